# Optimizing an MI355X kernel written in HIP

```python
import jax, jax.numpy as jnp
from jax import lax
import numpy as np

D_MODEL = 1024
BATCH = 32
SEQ = 2048
DEPTH = 1

POOL_WIDTH = D_MODEL // 2
POOL_GROUPS = 4
POOL_GROUP_DIM = POOL_WIDTH // POOL_GROUPS
POOL_WINDOWS = (2, 4, 8, 16)
N_HEADS = 8
HEAD_DIM = 64
ATTN_WIDTH = N_HEADS * HEAD_DIM
KV_DIM = HEAD_DIM
IDX_HEADS = 8
IDX_DIM = 64
TOPK_MAX = 256
ROPE_THETA = 500000.0
ROT_DIM = HEAD_DIM // 4
Q_BLOCK = 128
EPS = 1e-6

IN_SIZES = (
    POOL_WIDTH,
    POOL_WIDTH,
    ATTN_WIDTH,
    KV_DIM,
    KV_DIM,
    ATTN_WIDTH,
    IDX_HEADS * IDX_DIM,
    IDX_DIM,
    IDX_HEADS,
    D_MODEL,
    D_MODEL,
)
IN_WIDTH = 2 * POOL_WIDTH + 2 * ATTN_WIDTH + 2 * KV_DIM + IDX_HEADS * IDX_DIM + IDX_DIM + IDX_HEADS + 2 * D_MODEL

kernel_name = "hybrid_pool_dsa_gated_block"


def rmsnorm(x, gain):
    xf = x.astype(jnp.float32)
    out = xf * lax.rsqrt(jnp.mean(xf * xf, axis=-1, keepdims=True) + EPS)
    return (out * gain.astype(jnp.float32)).astype(x.dtype)


def rope_tables(positions):
    inv_freq = ROPE_THETA ** (-jnp.arange(0, ROT_DIM, 2, dtype=jnp.float32) / ROT_DIM)
    ang = positions.astype(jnp.float32)[..., None] * inv_freq
    return jnp.cos(ang)[:, :, None, :], jnp.sin(ang)[:, :, None, :]


def apply_partial_rope(x, cos, sin):
    half = ROT_DIM // 2
    x1 = x[..., :half].astype(jnp.float32)
    x2 = x[..., half:ROT_DIM].astype(jnp.float32)
    rot = jnp.concatenate([x1 * cos - x2 * sin, x2 * cos + x1 * sin], axis=-1)
    return jnp.concatenate([rot.astype(x.dtype), x[..., ROT_DIM:]], axis=-1)


def multiscale_pool(u, w_group, scale):
    B, L, _ = u.shape
    ug = u.reshape(B, L, POOL_GROUPS, POOL_GROUP_DIM).astype(jnp.float32)
    cs = jnp.cumsum(ug, axis=1)
    cs_pad = jnp.concatenate([jnp.zeros_like(cs[:, :1]), cs], axis=1)
    t = jnp.arange(L)
    groups = []
    for g, w in enumerate(POOL_WINDOWS):
        start = jnp.maximum(t + 1 - w, 0)
        win_sum = cs[:, :, g] - cs_pad[:, start, g]
        count = (t + 1 - start).astype(jnp.float32)[None, :, None]
        groups.append(win_sum / count - ug[:, :, g])
    pooled = jnp.stack(groups, axis=2).astype(u.dtype)
    mixed = jnp.einsum('blgc,gcd->blgd', pooled, w_group)
    return mixed.reshape(B, L, POOL_WIDTH) * scale


def dsa_sparse_attention(q, k, v, q_idx, k_idx, w_idx):
    B, L = q.shape[0], q.shape[1]
    n_blk = L // Q_BLOCK
    top_k = min(TOPK_MAX, L // 4)
    attn_scale = HEAD_DIM ** -0.5
    key_pos = jnp.arange(L)
    k_idx_f = k_idx.astype(jnp.float32)

    def to_blocks(a):
        return a.reshape((B, n_blk, Q_BLOCK) + a.shape[2:]).swapaxes(0, 1)

    def block(args):
        qb, qib, wb, blk = args
        tq = blk * Q_BLOCK + jnp.arange(Q_BLOCK)
        s = jax.nn.relu(jnp.einsum('bqhd,bsd->bqhs', qib.astype(jnp.float32), k_idx_f))
        score = jnp.einsum('bqhs,bqh->bqs', s, wb.astype(jnp.float32))
        causal = key_pos[None, :] <= tq[:, None]
        score = jnp.where(causal[None], score, -jnp.inf)
        _, idx = lax.top_k(score, top_k)
        k_sel = jax.vmap(lambda kb, ib: kb[ib])(k, idx)
        v_sel = jax.vmap(lambda vb, ib: vb[ib])(v, idx)
        logits = jnp.einsum('bqhd,bqkd->bqhk', qb, k_sel).astype(jnp.float32) * attn_scale
        valid = idx <= tq[None, :, None]
        logits = jnp.where(valid[:, :, None, :], logits, -jnp.inf)
        p = jax.nn.softmax(logits, axis=-1).astype(v.dtype)
        return jnp.einsum('bqhk,bqkd->bqhd', p, v_sel)

    out = lax.map(block, (to_blocks(q), to_blocks(q_idx), to_blocks(w_idx), jnp.arange(n_blk)))
    return out.swapaxes(0, 1).reshape(B, L, N_HEADS * HEAD_DIM)


def setup_inputs(seed: int = 0) -> dict:
    key = jax.random.key(seed)
    ks = jax.random.split(key, 16)
    f32 = jnp.float32
    x = jax.random.normal(ks[0], (BATCH, SEQ, D_MODEL), f32)
    c = jax.random.normal(ks[1], (BATCH, D_MODEL), f32)
    offsets = jax.random.randint(ks[2], (BATCH, 1), 0, 1024, dtype=jnp.int32)
    positions = offsets + jnp.arange(SEQ, dtype=jnp.int32)[None, :]
    w_ada = jax.random.normal(ks[3], (DEPTH, D_MODEL, 3 * D_MODEL), f32) * (0.5 * D_MODEL ** -0.5)
    b_ada = jax.random.normal(ks[4], (DEPTH, 3 * D_MODEL), f32) * 0.02
    norm_gain = 1.0 + 0.02 * jax.random.normal(ks[5], (DEPTH, D_MODEL), f32)
    w_in = jax.random.normal(ks[6], (DEPTH, D_MODEL, IN_WIDTH), f32) * D_MODEL ** -0.5
    w_pool_group = jax.random.normal(ks[7], (DEPTH, POOL_GROUPS, POOL_GROUP_DIM, POOL_GROUP_DIM), f32) * POOL_GROUP_DIM ** -0.5
    pool_scale = 1.0 + 0.02 * jax.random.normal(ks[8], (DEPTH, POOL_WIDTH), f32)
    q_norm_gain = 1.0 + 0.02 * jax.random.normal(ks[9], (DEPTH, HEAD_DIM), f32)
    k_norm_gain = 1.0 + 0.02 * jax.random.normal(ks[10], (DEPTH, HEAD_DIM), f32)
    w_branch_a = jax.random.normal(ks[11], (DEPTH, POOL_WIDTH, D_MODEL), f32) * POOL_WIDTH ** -0.5
    w_branch_b = jax.random.normal(ks[12], (DEPTH, ATTN_WIDTH, D_MODEL), f32) * ATTN_WIDTH ** -0.5
    w_out = jax.random.normal(ks[13], (DEPTH, D_MODEL, D_MODEL), f32) * D_MODEL ** -0.5
    return {"x": x, "c": c, "positions": positions, "w_ada": w_ada, "b_ada": b_ada,
            "norm_gain": norm_gain, "w_in": w_in, "w_pool_group": w_pool_group,
            "pool_scale": pool_scale, "q_norm_gain": q_norm_gain, "k_norm_gain": k_norm_gain,
            "w_branch_a": w_branch_a, "w_branch_b": w_branch_b, "w_out": w_out}


def reference(x, c, positions, w_ada, b_ada, norm_gain, w_in, w_pool_group, pool_scale,
              q_norm_gain, k_norm_gain, w_branch_a, w_branch_b, w_out):
    B, L, _ = x.shape
    cos, sin = rope_tables(positions)
    split_points = tuple(int(s) for s in np.cumsum(IN_SIZES)[:-1])
    idx_w_scale = (IDX_HEADS ** -0.5) * (IDX_DIM ** -0.5)
    for layer in range(DEPTH):
        mod = jax.nn.silu(c) @ w_ada[layer] + b_ada[layer]
        shift, scale, gate = jnp.split(mod, 3, axis=-1)
        h = rmsnorm(x, norm_gain[layer]) * (1.0 + scale[:, None, :]) + shift[:, None, :]

        proj = h @ w_in[layer]
        (u_a, z_a, q, k, v, z_b, q_idx, k_idx, w_idx, g_a, g_b) = jnp.split(proj, split_points, axis=-1)

        y_a = multiscale_pool(u_a, w_pool_group[layer], pool_scale[layer]) * jax.nn.silu(z_a)

        q = apply_partial_rope(rmsnorm(q.reshape(B, L, N_HEADS, HEAD_DIM), q_norm_gain[layer]), cos, sin)
        k = apply_partial_rope(rmsnorm(k.reshape(B, L, 1, KV_DIM), k_norm_gain[layer]), cos, sin)[:, :, 0]
        q_idx = apply_partial_rope(q_idx.reshape(B, L, IDX_HEADS, IDX_DIM), cos, sin)
        k_idx = apply_partial_rope(k_idx.reshape(B, L, 1, IDX_DIM), cos, sin)[:, :, 0]
        attn = dsa_sparse_attention(q, k, v, q_idx, k_idx, w_idx * idx_w_scale)
        y_b = attn * jax.nn.silu(z_b)

        merged = jax.nn.sigmoid(g_a) * (y_a @ w_branch_a[layer]) + jax.nn.sigmoid(g_b) * (y_b @ w_branch_b[layer])
        x = x + gate[:, None, :] * (merged @ w_out[layer])
    return x
```

```cpp
#include <hip/hip_runtime.h>
#include <cstdio>
#include <cstdint>
#include <cmath>
namespace nv {
constexpr int D = 1024, B = 32, L = 2048, INW = 4808;
constexpr int O_UA = 0, O_ZA = 512, O_Q = 1024, O_K = 1536, O_V = 1600, O_ZB = 1664, O_QI = 2176, O_KI = 2688, O_WI = 2752, O_GA = 2760, O_GB = 3784;

__device__ __forceinline__ float siluf(float v) { return v / (1.f + expf(-v)); }
__device__ __forceinline__ float sigmf(float v) { return 1.f / (1.f + expf(-v)); }

__global__ void __launch_bounds__(256) n_mod(const float* c, const float* w_ada, const float* b_ada, float* mod) {
    const int j = blockIdx.x * 256 + threadIdx.x, b = blockIdx.y;
    float acc = 0.f;
    for (int k = 0; k < D; ++k) { const float cv = c[b * D + k]; acc += siluf(cv) * w_ada[(size_t)k * 3072 + j]; }
    mod[b * 3072 + j] = acc + b_ada[j];
}

__global__ void __launch_bounds__(256) n_h(const float* x, const float* gain, const float* mod, float* h, int b) {
    __shared__ float red[256];
    const int t = blockIdx.x, tid = threadIdx.x;
    const float* xr = x + ((size_t)b * L + t) * D;
    float v[4]; float ss = 0.f;
#pragma unroll
    for (int i = 0; i < 4; ++i) { v[i] = xr[tid + 256 * i]; ss += v[i] * v[i]; }
    red[tid] = ss; __syncthreads();
    for (int s = 128; s > 0; s >>= 1) { if (tid < s) red[tid] += red[tid + s]; __syncthreads(); }
    const float rinv = rsqrtf(red[0] * (1.f / D) + 1e-6f);
#pragma unroll
    for (int i = 0; i < 4; ++i) { const int k = tid + 256 * i; const float o = v[i] * rinv * gain[k];
        h[(size_t)t * D + k] = o * (1.f + mod[b * 3072 + 1024 + k]) + mod[b * 3072 + k]; }
}

__global__ void __launch_bounds__(256) n_sgemm(const float* A, int lda, const float* Bm, int ldb, float* C, int ldc, int M, int N, int K) {
    __shared__ float As[16][65], Bs[16][65];
    const int tid = threadIdx.x, tx = tid & 15, ty = tid >> 4;
    const int m0 = blockIdx.y * 64, n0 = blockIdx.x * 64;
    float acc[4][4];
#pragma unroll
    for (int i = 0; i < 4; ++i)
#pragma unroll
        for (int j = 0; j < 4; ++j) acc[i][j] = 0.f;
    for (int k0 = 0; k0 < K; k0 += 16) {
#pragma unroll
        for (int i = 0; i < 4; ++i) { const int idx = tid + 256 * i; const int r = idx >> 4, kk = idx & 15; As[kk][r] = A[(size_t)(m0 + r) * lda + k0 + kk]; }
#pragma unroll
        for (int i = 0; i < 4; ++i) { const int idx = tid + 256 * i; const int kk = idx >> 6, cc = idx & 63; Bs[kk][cc] = (n0 + cc < N) ? Bm[(size_t)(k0 + kk) * ldb + n0 + cc] : 0.f; }
        __syncthreads();
#pragma unroll
        for (int kk = 0; kk < 16; ++kk) {
            float a[4], bb[4];
#pragma unroll
            for (int i = 0; i < 4; ++i) { a[i] = As[kk][ty * 4 + i]; bb[i] = Bs[kk][tx * 4 + i]; }
#pragma unroll
            for (int i = 0; i < 4; ++i)
#pragma unroll
                for (int j = 0; j < 4; ++j) acc[i][j] += a[i] * bb[j];
        }
        __syncthreads();
    }
#pragma unroll
    for (int i = 0; i < 4; ++i)
#pragma unroll
        for (int j = 0; j < 4; ++j) { const int n = n0 + tx * 4 + j; if (n < N) C[(size_t)(m0 + ty * 4 + i) * ldc + n] = acc[i][j]; }
}

__device__ __forceinline__ void rope_cs(int pos, int i, float& cs, float& sn) {
    const float inv_freq = powf(500000.0f, -(float)(2 * i) / 16.0f);
    const float ang = (float)pos * inv_freq;
    const float k = rintf(ang * 0.15915494309189535f);
    float r = fmaf(-k, 6.2831854820251465f, ang);
    r = fmaf(-k, -1.7484556000744487e-07f, r);
    cs = cosf(r); sn = sinf(r);
}

__global__ void __launch_bounds__(256) n_heads(const float* proj, const int* positions, const float* qg, const float* kg, float* qn, float* kn, float* qi, float* ki, int b) {
    const int id = blockIdx.x * 256 + threadIdx.x; if (id >= L * 18) return;
    const int t = id / 18, slot = id % 18;
    const float* pr = proj + (size_t)t * INW;
    const float* src; float* dst; const float* g = nullptr;
    if (slot < 8) { src = pr + O_Q + slot * 64; dst = qn + ((size_t)t * 8 + slot) * 64; g = qg; }
    else if (slot == 8) { src = pr + O_K; dst = kn + (size_t)t * 64; g = kg; }
    else if (slot < 17) { src = pr + O_QI + (slot - 9) * 64; dst = qi + ((size_t)t * 8 + (slot - 9)) * 64; }
    else { src = pr + O_KI; dst = ki + (size_t)t * 64; }
    float rinv = 1.f;
    if (g) { float ss = 0.f; for (int d = 0; d < 64; ++d) ss += src[d] * src[d]; rinv = rsqrtf(ss * (1.f / 64.f) + 1e-6f); }
    const int pos = positions[b * L + t];
    for (int d = 16; d < 64; ++d) dst[d] = g ? src[d] * rinv * g[d] : src[d];
    for (int i = 0; i < 8; ++i) {
        float cs, sn; rope_cs(pos, i, cs, sn);
        const float x1 = g ? src[i] * rinv * g[i] : src[i], x2 = g ? src[i + 8] * rinv * g[i + 8] : src[i + 8];
        dst[i] = x1 * cs - x2 * sn; dst[i + 8] = x2 * cs + x1 * sn;
    }
}

__global__ void __launch_bounds__(256) n_pool(const float* proj, float* pooled) {
    const int id = blockIdx.x * 256 + threadIdx.x; const int t = id >> 9, ch = id & 511;
    const int g = ch >> 7; const int w = 2 << g;
    const int start = (t + 1 - w) > 0 ? (t + 1 - w) : 0;
    float s = 0.f; for (int j = start; j <= t; ++j) s += proj[(size_t)j * INW + O_UA + ch];
    pooled[(size_t)t * 512 + ch] = s / (float)(t + 1 - start) - proj[(size_t)t * INW + O_UA + ch];
}

__global__ void __launch_bounds__(256) n_mix(const float* proj, const float* pooled, const float* wpg, const float* pscale, float* ya) {
    const int id = blockIdx.x * 256 + threadIdx.x; const int t = id >> 9, col = id & 511; const int g = col >> 7, d = col & 127;
    float acc = 0.f; for (int c = 0; c < 128; ++c) acc += pooled[(size_t)t * 512 + g * 128 + c] * wpg[((size_t)g * 128 + c) * 128 + d];
    ya[(size_t)t * 512 + col] = acc * pscale[col] * siluf(proj[(size_t)t * INW + O_ZA + col]);
}

__global__ void __launch_bounds__(256) n_score(const float* proj, const float* qi, const float* ki, float* score) {
    const int s = blockIdx.x * 256 + threadIdx.x, q = blockIdx.y;
    float out = -INFINITY;
    if (s <= q) {
        const float wsc = 0.35355339059327373f * 0.125f;
        float acc = 0.f;
        for (int h = 0; h < 8; ++h) { float dt = 0.f; for (int d = 0; d < 64; ++d) dt += qi[((size_t)q * 8 + h) * 64 + d] * ki[(size_t)s * 64 + d];
            acc += fmaxf(dt, 0.f) * (proj[(size_t)q * INW + O_WI + h] * wsc); }
        out = acc;
    }
    score[(size_t)q * L + s] = out;
}

__global__ void __launch_bounds__(256) n_attn(const float* proj, const float* score, const float* qn, const float* kn, float* yb) {
    __shared__ float sc[L]; __shared__ int sel[256]; __shared__ float p[8][256]; __shared__ float qs[512]; __shared__ float red[256]; __shared__ float lsum[8];
    const int q = blockIdx.x, tid = threadIdx.x; const int nv = q + 1;
    for (int s = tid; s < L; s += 256) sc[s] = score[(size_t)q * L + s];
    for (int i = tid; i < 512; i += 256) qs[i] = qn[(size_t)q * 512 + i];
    __syncthreads();
    const int cnt = nv < 256 ? nv : 256;
    for (int s = tid; s < nv; s += 256) { const float v = sc[s]; int rank = 0;
        for (int s2 = 0; s2 < nv; ++s2) { const float v2 = sc[s2]; rank += (v2 > v || (v2 == v && s2 < s)) ? 1 : 0; }
        if (rank < 256) sel[rank] = s; }
    __syncthreads();
    float lg[8];
    if (tid < cnt) { const int s = sel[tid];
_Pragma("unroll")
        for (int h = 0; h < 8; ++h) { float dt = 0.f; for (int d = 0; d < 64; ++d) dt += qs[h * 64 + d] * kn[(size_t)s * 64 + d]; lg[h] = dt * 0.125f; } }
_Pragma("unroll")
    for (int h = 0; h < 8; ++h) {
        red[tid] = tid < cnt ? lg[h] : -INFINITY; __syncthreads();
        for (int st = 128; st > 0; st >>= 1) { if (tid < st) red[tid] = fmaxf(red[tid], red[tid + st]); __syncthreads(); }
        const float mx = red[0]; __syncthreads();
        const float e = tid < cnt ? expf(lg[h] - mx) : 0.f; p[h][tid] = e; red[tid] = e; __syncthreads();
        for (int st = 128; st > 0; st >>= 1) { if (tid < st) red[tid] += red[tid + st]; __syncthreads(); }
        if (tid == 0) lsum[h] = red[0]; __syncthreads();
    }
    for (int o = tid; o < 512; o += 256) { const int h = o >> 6, d = o & 63; float acc = 0.f;
        for (int j = 0; j < cnt; ++j) acc += p[h][j] * proj[(size_t)sel[j] * INW + O_V + d];
        yb[(size_t)q * 512 + o] = acc / lsum[h] * siluf(proj[(size_t)q * INW + O_ZB + o]); }
}

__global__ void __launch_bounds__(256) n_merge(const float* proj, const float* ta, const float* tb, float* merged) {
    const int id = blockIdx.x * 256 + threadIdx.x; const int t = id >> 10, col = id & 1023;
    merged[id] = sigmf(proj[(size_t)t * INW + O_GA + col]) * ta[id] + sigmf(proj[(size_t)t * INW + O_GB + col]) * tb[id];
}
__global__ void __launch_bounds__(256) n_out(const float* x, const float* mod, const float* to, float* out, int b) {
    const int id = blockIdx.x * 256 + threadIdx.x; const int col = id & 1023;
    const size_t g = (size_t)b * L * D + id;
    out[g] = x[g] + mod[b * 3072 + 2048 + col] * to[id];
}

static void run(void* const* d_in, float* out, unsigned char* ws, hipStream_t st) {
    const float* x = (const float*)d_in[0]; const float* c = (const float*)d_in[1]; const int* positions = (const int*)d_in[2];
    const float* w_ada = (const float*)d_in[3]; const float* b_ada = (const float*)d_in[4]; const float* gain = (const float*)d_in[5];
    const float* w_in = (const float*)d_in[6]; const float* wpg = (const float*)d_in[7]; const float* pscale = (const float*)d_in[8];
    const float* qg = (const float*)d_in[9]; const float* kg = (const float*)d_in[10]; const float* w_a = (const float*)d_in[11];
    const float* w_b = (const float*)d_in[12]; const float* w_out = (const float*)d_in[13];
    size_t off = 0; auto take = [&](size_t n) { float* p = (float*)(ws + off); off += (n * 4 + 255) / 256 * 256; return p; };
    float* mod = take(32 * 3072); float* h = take((size_t)L * D); float* proj = take((size_t)L * INW);
    float* qn = take((size_t)L * 512); float* kn = take((size_t)L * 64); float* qi = take((size_t)L * 512); float* ki = take((size_t)L * 64);
    float* pooled = take((size_t)L * 512); float* ya = take((size_t)L * 512); float* score = take((size_t)L * L); float* yb = take((size_t)L * 512);
    float* ta = take((size_t)L * D); float* tb = take((size_t)L * D); float* merged = take((size_t)L * D); float* to = take((size_t)L * D);
    n_mod<<<dim3(12, 32), 256, 0, st>>>(c, w_ada, b_ada, mod);
    for (int b = 0; b < B; ++b) {
        n_h<<<L, 256, 0, st>>>(x, gain, mod, h, b);
        n_sgemm<<<dim3((INW + 63) / 64, L / 64), 256, 0, st>>>(h, D, w_in, INW, proj, INW, L, INW, D);
        n_heads<<<(L * 18 + 255) / 256, 256, 0, st>>>(proj, positions, qg, kg, qn, kn, qi, ki, b);
        n_pool<<<L * 512 / 256, 256, 0, st>>>(proj, pooled);
        n_mix<<<L * 512 / 256, 256, 0, st>>>(proj, pooled, wpg, pscale, ya);
        n_score<<<dim3(L / 256, L), 256, 0, st>>>(proj, qi, ki, score);
        n_attn<<<L, 256, 0, st>>>(proj, score, qn, kn, yb);
        n_sgemm<<<dim3(D / 64, L / 64), 256, 0, st>>>(ya, 512, w_a, D, ta, D, L, D, 512);
        n_sgemm<<<dim3(D / 64, L / 64), 256, 0, st>>>(yb, 512, w_b, D, tb, D, L, D, 512);
        n_merge<<<L * D / 256, 256, 0, st>>>(proj, ta, tb, merged);
        n_sgemm<<<dim3(D / 64, L / 64), 256, 0, st>>>(merged, D, w_out, D, to, D, L, D, D);
        n_out<<<L * D / 256, 256, 0, st>>>(x, mod, to, out, b);
    }
}
}

extern "C" void kernel_launch(void* const* d_in, const int* in_sizes, int n_in, void* d_out, int out_size, void* d_ws, size_t ws_size, hipStream_t stream) {
    nv::run(d_in, (float*)d_out, (unsigned char*)d_ws, stream);
}
```

```cpp
#include <hip/hip_runtime.h>
#include <hip/hip_cooperative_groups.h>
#include <cstdio>
#include <cstdint>
#include <cmath>
namespace cg = cooperative_groups;

#define LAS __attribute__((address_space(3)))
typedef unsigned short bf16_t;
typedef short bf16x8 __attribute__((ext_vector_type(8)));
typedef _Float16 f16x8 __attribute__((ext_vector_type(8)));
typedef float f32x2 __attribute__((ext_vector_type(2)));
typedef float f32x4 __attribute__((ext_vector_type(4)));
typedef float f32x16 __attribute__((ext_vector_type(16)));
typedef unsigned u32x2 __attribute__((ext_vector_type(2)));
typedef unsigned u32x4 __attribute__((ext_vector_type(4)));
typedef short s16x4 __attribute__((ext_vector_type(4)));

constexpr int BATCH = 32, SEQ = 2048, DMODEL = 1024, MROWS = BATCH * SEQ, NPROJ = 4864  ;
constexpr float EPS = 1e-6f;
constexpr float LOG2E = 1.4426950408889634f;
constexpr float C2 = 0.125f * LOG2E;

constexpr size_t MiB = 1u << 20;
constexpr size_t WS_CTL = 0, CTL_ZERO_BYTES = 1 * MiB;
constexpr size_t WS_MOD = 64 * 1024;
constexpr size_t WS_WIN = 2 * MiB, WS_WPG = 12 * MiB, WS_WA = 13 * MiB, WS_WB = 14 * MiB, WS_WOUT = 15 * MiB;
constexpr size_t WS_K = 18 * MiB, WS_V = 26 * MiB, WS_KI = 34 * MiB, WS_WI = 42 * MiB;
constexpr size_t WS_H = 64 * MiB;
constexpr size_t WS_UA = 192 * MiB;
constexpr size_t WS_POOL = 256 * MiB, WS_ZA = 320 * MiB, WS_Q = 384 * MiB  , WS_ZB = 448 * MiB, WS_QI = 512 * MiB;
constexpr size_t WS_GA = 576 * MiB, WS_GB = 704 * MiB, WS_END = 832 * MiB;

constexpr int NWAVES = 8, NTHREADS = 512;
constexpr int RING_BYTES = 131072, LDS_BYTES = 147456;

__device__ __forceinline__ float wave_sum(float v) {
#pragma unroll
    for (int o = 1; o < 64; o <<= 1) v += __shfl_xor(v, o);
    return v;
}
typedef __bf16 bf16x2_t __attribute__((ext_vector_type(2)));
__device__ __forceinline__ unsigned cvt_pk_bf16(float lo, float hi) { const f32x2 v = {lo, hi}; const bf16x2_t b = __builtin_convertvector(v, bf16x2_t); return __builtin_bit_cast(unsigned, b); }
__device__ __forceinline__ unsigned pk_f16(float lo, float hi) { const _Float16 a = (_Float16)lo, b = (_Float16)hi; return (unsigned)__builtin_bit_cast(unsigned short, a) | ((unsigned)__builtin_bit_cast(unsigned short, b) << 16); }
__device__ __forceinline__ float bf_lo(unsigned w) { return __uint_as_float(w << 16); }
__device__ __forceinline__ float bf_hi(unsigned w) { return __uint_as_float(w & 0xffff0000u); }
__device__ __forceinline__ float fast_sigmoid(float v) { return __builtin_amdgcn_rcpf(1.0f + __builtin_amdgcn_exp2f(-LOG2E * v)); }
__device__ __forceinline__ float fast_silu(float v) { return v * fast_sigmoid(v); }

namespace pg8 {
constexpr int BM = 256, BK = 64, HALF = 128, HTB = HALF * BK * 2, STAGE_BYTES = 8 * HTB, NXCD = 8, WGM = 8;
__host__ __device__ __forceinline__ int lds_byte(int r, int c) { const int st = (r >> 4) * 2 + (c >> 5), rr = r & 15, cc = c & 31, ob = rr * 64 + cc * 2; return st * 1024 + (ob ^ (((ob >> 9) & 1) << 5)); }
__host__ __device__ __forceinline__ void stage_rc(int b, int& R, int& C) { const int st = b / 1024, sb = b % 1024, swz = sb ^ (((sb >> 9) & 1) << 5); R = (st >> 1) * 16 + swz / 64; C = (st & 1) * 32 + (swz % 64) / 2; }
__host__ __device__ __forceinline__ int perm32(int rho) { const int n = rho >> 4, i = rho & 15; return 8 * (i >> 2) + 4 * n + (i & 3); }

struct Unit { int pm, pn, z; };
__device__ __forceinline__ void tile_of(int L, int nM, int nN, int& pm, int& pn) {
    const int nwg = nM * nN; int wgid = L;
    { const int q = nwg / NXCD, r = nwg % NXCD, xcd = wgid % NXCD, off = wgid / NXCD; wgid = (xcd < r ? xcd * (q + 1) : r * (q + 1) + (xcd - r) * q) + off; }
    const int nig = WGM * nN, gid = wgid / nig, fm = gid * WGM, gsz = (nM - fm) < WGM ? (nM - fm) : WGM;
    pm = fm + ((wgid % nig) % gsz); pn = (wgid % nig) / gsz;
}

template <class Epi, class Sched>
__device__ __forceinline__ void gemm_phase(LAS unsigned char* lds, const int K, const int lda, const int ldb, const Sched& S, const Epi& E) {
    const int tid = threadIdx.x, wid = __builtin_amdgcn_readfirstlane(tid >> 6), lane = tid & 63, wr = wid >> 2, wc = wid & 3, fr = lane & 15, fq = lane >> 4;
    int nt = K / BK; asm volatile("" : "+s"(nt));
    unsigned voffA[2], voffB[2];
#pragma unroll
    for (int i = 0; i < 2; ++i) { int R, C; stage_rc(tid * 16 + i * 8192, R, C); const int Rb = Epi::PERM ? ((R & ~31) + perm32(R & 31)) : R;
        voffA[i] = (unsigned)(R * lda + C) * 2u; voffB[i] = (unsigned)(Rb * ldb + C) * 2u; }
    const size_t kstep = (size_t)(BK * 2);
    const size_t hstepA = (size_t)HALF * lda * 2, hstepB = (size_t)HALF * ldb * 2;
    const unsigned ldsw = (unsigned)wid * 1024u;
    const int aoff = lds_byte(wr * 64 + fr, fq * 8), boff = lds_byte(wc * 32 + fr, fq * 8);
#define PG8_SA(b, h) (((b) * 2 + (h)) * HTB)
#define PG8_SB(b, h) ((4 + (b) * 2 + (h)) * HTB)
#define PG8_STAGE(bufoff, gbase, voff) do { _Pragma("unroll") for (int _i = 0; _i < 2; ++_i) \
        __builtin_amdgcn_global_load_lds((const unsigned*)((const char*)(gbase) + (voff)[_i]), (LAS unsigned*)(lds + (bufoff) + ldsw + _i * 8192), 16, 0, 0); } while (0)
#define PG8_LDA(dst, b, h) do { _Pragma("unroll") for (int m = 0; m < 4; ++m) _Pragma("unroll") for (int k = 0; k < 2; ++k) dst[m][k] = *(const LAS bf16x8*)(lds + PG8_SA(b, h) + aoff + m * 2048 + k * 1024); } while (0)
#define PG8_LDB(dst, b, h) do { _Pragma("unroll") for (int n = 0; n < 2; ++n) _Pragma("unroll") for (int k = 0; k < 2; ++k) dst[n][k] = *(const LAS bf16x8*)(lds + PG8_SB(b, h) + boff + n * 2048 + k * 1024); } while (0)
#define PG8_MMA(ai, bj, At, Bt) do { __builtin_amdgcn_s_setprio(1); _Pragma("unroll") for (int m = 0; m < 4; ++m) _Pragma("unroll") for (int n = 0; n < 2; ++n) _Pragma("unroll") for (int k = 0; k < 2; ++k) \
        acc[ai][bj][m][n] = __builtin_amdgcn_mfma_f32_16x16x32_bf16(Bt[n][k], At[m][k], acc[ai][bj][m][n], 0, 0, 0); __builtin_amdgcn_s_setprio(0); } while (0)
#define PG8_WAIT_V(n) asm volatile("s_waitcnt vmcnt(" #n ")" ::: "memory")
#define PG8_WAIT_L(n) asm volatile("s_waitcnt lgkmcnt(" #n ")" ::: "memory")
#define PG8_BAR __builtin_amdgcn_s_barrier()
#define PG8_SCHED __builtin_amdgcn_sched_barrier(0)
    Unit cur, nxt; int ui = 0;
    if (!S.next(0, cur)) return;
    f32x4 acc[2][2][4][2];
#pragma unroll
    for (int a = 0; a < 2; ++a)
#pragma unroll
        for (int b = 0; b < 2; ++b)
#pragma unroll
            for (int m = 0; m < 4; ++m)
#pragma unroll
                for (int n = 0; n < 2; ++n) acc[a][b][m][n] = (f32x4){0.f, 0.f, 0.f, 0.f};
    bf16x8 At[4][2], B0[2][2], B1[2][2];
    const char* cA = S.a_base(cur); const char* cB = S.b_base(cur);
    PG8_STAGE(PG8_SB(0, 0), cB, voffB); PG8_STAGE(PG8_SB(0, 1), cB + hstepB, voffB); PG8_STAGE(PG8_SA(0, 0), cA, voffA); PG8_STAGE(PG8_SA(0, 1), cA + hstepA, voffA);
    if (wr == 1) PG8_BAR;
    PG8_WAIT_V(2); PG8_BAR;
    PG8_STAGE(PG8_SB(1, 0), cB + kstep, voffB); PG8_STAGE(PG8_SA(1, 0), cA + kstep, voffA); PG8_STAGE(PG8_SB(1, 1), cB + hstepB + kstep, voffB);
    PG8_WAIT_V(6); PG8_BAR;
    for (;;) {
        const bool has_next = S.next(ui + 1, nxt);
        const char* nA = has_next ? S.a_base(nxt) : cA; const char* nB = has_next ? S.b_base(nxt) : cB;
        for (int t = 0; t < nt; t += 2) {
            const bool last = (t == nt - 2);
            const char* a1 = cA + (size_t)(t + 1) * kstep;
            const char* a2 = last ? nA : cA + (size_t)(t + 2) * kstep; const char* b2 = last ? nB : cB + (size_t)(t + 2) * kstep;
            const char* a3 = a2 + kstep; const char* b3 = b2 + kstep;
            PG8_LDB(B0, 0, 0); PG8_LDB(B1, 0, 1); PG8_SCHED; PG8_LDA(At, 0, 0); PG8_STAGE(PG8_SA(1, 1), a1 + hstepA, voffA);
            PG8_WAIT_V(8); PG8_WAIT_L(0); PG8_BAR; PG8_MMA(0, 0, At, B0); PG8_MMA(0, 1, At, B1); PG8_BAR; PG8_SCHED;
            PG8_LDA(At, 0, 1); PG8_STAGE(PG8_SB(0, 0), b2, voffB); PG8_STAGE(PG8_SB(0, 1), b2 + hstepB, voffB); PG8_STAGE(PG8_SA(0, 0), a2, voffA);
            PG8_WAIT_V(8); PG8_WAIT_L(0); PG8_BAR; PG8_MMA(1, 0, At, B0); PG8_MMA(1, 1, At, B1); PG8_BAR; PG8_SCHED;
            PG8_LDB(B0, 1, 0); PG8_LDB(B1, 1, 1); PG8_SCHED; PG8_LDA(At, 1, 0); PG8_STAGE(PG8_SA(0, 1), a2 + hstepA, voffA);
            PG8_WAIT_V(8); PG8_WAIT_L(0); PG8_BAR; PG8_MMA(0, 0, At, B0); PG8_MMA(0, 1, At, B1); PG8_BAR; PG8_SCHED;
            PG8_LDA(At, 1, 1); PG8_STAGE(PG8_SB(1, 0), b3, voffB); PG8_STAGE(PG8_SB(1, 1), b3 + hstepB, voffB); PG8_STAGE(PG8_SA(1, 0), a3, voffA);
            PG8_WAIT_V(8); PG8_WAIT_L(0); PG8_BAR; PG8_MMA(1, 0, At, B0); PG8_MMA(1, 1, At, B1); PG8_BAR; PG8_SCHED;
        }
        if (wr == 0) PG8_BAR;
        E(acc, cur, wr, wc, fr, fq);
        if (!has_next) break;
#pragma unroll
        for (int a = 0; a < 2; ++a)
#pragma unroll
            for (int b = 0; b < 2; ++b)
#pragma unroll
                for (int m = 0; m < 4; ++m)
#pragma unroll
                    for (int n = 0; n < 2; ++n) acc[a][b][m][n] = (f32x4){0.f, 0.f, 0.f, 0.f};
        cur = nxt; cA = nA; cB = nB; ++ui;
        if (wr == 1) PG8_BAR;
    }
    PG8_WAIT_V(0);
    PG8_BAR;
#undef PG8_SA
#undef PG8_SB
#undef PG8_STAGE
#undef PG8_LDA
#undef PG8_LDB
#undef PG8_MMA
#undef PG8_WAIT_V
#undef PG8_WAIT_L
#undef PG8_BAR
#undef PG8_SCHED
}

template <class Epi, class Sched>
__device__ __forceinline__ void slow_gemm_phase(LAS unsigned char* lds, const int K, const int lda, const int ldb, const Sched& S, const Epi& E) {
    const int tid = threadIdx.x, wid = __builtin_amdgcn_readfirstlane(tid >> 6), lane = tid & 63, wr = wid >> 2, wc = wid & 3, fr = lane & 15, fq = lane >> 4;
    Unit u;
    for (int ui = 0; S.next(ui, u); ++ui) {
        f32x4 acc[2][2][4][2];
#pragma unroll
        for (int a = 0; a < 2; ++a)
#pragma unroll
            for (int b = 0; b < 2; ++b)
#pragma unroll
                for (int m = 0; m < 4; ++m)
#pragma unroll
                    for (int n = 0; n < 2; ++n) acc[a][b][m][n] = (f32x4){0.f, 0.f, 0.f, 0.f};
        const char* pA = S.a_base(u); const char* pB = S.b_base(u);
        const unsigned ao = (unsigned)((64 * wr + fr) * lda * 2);
        const unsigned bo = (unsigned)((32 * wc + (Epi::PERM ? 8 * fq : 4 * fq)) * ldb * 2);
        for (int k0 = 0; k0 < K; k0 += 8, pA += 16, pB += 16) {
#pragma unroll
            for (int bj = 0; bj < 2; ++bj)
#pragma unroll
                for (int n = 0; n < 2; ++n)
#pragma unroll
                    for (int e = 0; e < 4; ++e) {
                        const int colr = Epi::PERM ? (128 * bj + 4 * n + e) : (128 * bj + 16 * n + e);
                        const u32x4 bw = *(const u32x4*)(pB + (bo + (unsigned)(colr * ldb * 2)));
#pragma unroll
                        for (int ai = 0; ai < 2; ++ai)
#pragma unroll
                            for (int m = 0; m < 4; ++m) {
                                const u32x4 aw = *(const u32x4*)(pA + (ao + (unsigned)((128 * ai + 16 * m) * lda * 2)));
                                float s = acc[ai][bj][m][n][e];
                                s += __uint_as_float(aw.x << 16) * __uint_as_float(bw.x << 16) + __uint_as_float(aw.x & 0xffff0000u) * __uint_as_float(bw.x & 0xffff0000u);
                                s += __uint_as_float(aw.y << 16) * __uint_as_float(bw.y << 16) + __uint_as_float(aw.y & 0xffff0000u) * __uint_as_float(bw.y & 0xffff0000u);
                                s += __uint_as_float(aw.z << 16) * __uint_as_float(bw.z << 16) + __uint_as_float(aw.z & 0xffff0000u) * __uint_as_float(bw.z & 0xffff0000u);
                                s += __uint_as_float(aw.w << 16) * __uint_as_float(bw.w << 16) + __uint_as_float(aw.w & 0xffff0000u) * __uint_as_float(bw.w & 0xffff0000u);
                                acc[ai][bj][m][n][e] = s;
                                asm volatile("" ::: "memory");
                            }
                    }
        }
        E(acc, u, wr, wc, fr, fq);
    }
    __syncthreads();
}
}

struct Args { const void* in[14]; float* out; unsigned char* ws; int ph_lo, ph_hi; };
struct Frame {
    LAS unsigned char* lds;
    int tid, lane, wave, vcu, G;
    const Args* a;
    __device__ __forceinline__ const float* inf(int i) const { return (const float*)a->in[i]; }
#define FIN(name, idx) __device__ __forceinline__ const float* name() const { return inf(idx); }
    FIN(x, 0) FIN(c, 1) FIN(w_ada, 3) FIN(b_ada, 4) FIN(gain, 5) FIN(w_in, 6) FIN(wpg, 7) FIN(pscale, 8) FIN(qg, 9) FIN(kg, 10) FIN(w_a, 11) FIN(w_b, 12) FIN(w_out, 13)
#undef FIN
    __device__ __forceinline__ const int* positions() const { return (const int*)a->in[2]; }
    __device__ __forceinline__ float* out() const { return a->out; }
#define FWS(type, name, off) __device__ __forceinline__ type* name() const { return (type*)(a->ws + (off)); }
    FWS(float, MOD, WS_MOD) FWS(float, WI, WS_WI) FWS(bf16_t, WIN, WS_WIN) FWS(bf16_t, WPG, WS_WPG) FWS(bf16_t, WA, WS_WA) FWS(bf16_t, WB, WS_WB) FWS(bf16_t, WOUT, WS_WOUT)
    FWS(bf16_t, H, WS_H) FWS(bf16_t, UA, WS_UA) FWS(bf16_t, POOL, WS_POOL) FWS(bf16_t, ZA, WS_ZA) FWS(bf16_t, Q, WS_Q) FWS(bf16_t, ZB, WS_ZB) FWS(bf16_t, GA, WS_GA) FWS(bf16_t, GB, WS_GB)
    FWS(bf16_t, KB, WS_K) FWS(bf16_t, VB, WS_V) FWS(_Float16, QI, WS_QI) FWS(_Float16, KI, WS_KI)
#undef FWS
};

__device__ __forceinline__ void p0_mod(Frame& F) {
    const int blk = blockIdx.x; if (blk >= 192) return;
    const int kc = blk & 3, cc = blk >> 2, k0 = 256 * kc, col0 = 64 * cc;
    LAS float* sc = (LAS float*)F.lds;
    LAS float* red = (LAS float*)(F.lds + 32768);
    for (int idx = F.tid; idx < 8192; idx += NTHREADS) { const int b = idx >> 8, kk = idx & 255; const float cv = F.c()[b * DMODEL + k0 + kk]; sc[kk * 32 + b] = cv / (1.0f + expf(-cv)); }
    __syncthreads();
    float acc[32];
#pragma unroll
    for (int b = 0; b < 32; ++b) acc[b] = 0.f;
    for (int kk = 32 * F.wave; kk < 32 * F.wave + 32; ++kk) {
        const float wv = F.w_ada()[(size_t)(k0 + kk) * 3072 + col0 + F.lane];
#pragma unroll
        for (int b4 = 0; b4 < 8; ++b4) { const f32x4 s = *(const LAS f32x4*)(sc + kk * 32 + 4 * b4);
            acc[4 * b4 + 0] += s[0] * wv; acc[4 * b4 + 1] += s[1] * wv; acc[4 * b4 + 2] += s[2] * wv; acc[4 * b4 + 3] += s[3] * wv; }
    }
#pragma unroll
    for (int b = 0; b < 32; ++b) red[(F.wave * 32 + b) * 64 + F.lane] = acc[b];
    __syncthreads();
    for (int o = F.tid; o < 2048; o += NTHREADS) { const int b = o >> 6, col = o & 63; float s = 0.f;
#pragma unroll
        for (int w = 0; w < 8; ++w) s += red[(w * 32 + b) * 64 + col];
        if (kc == 0) s += F.b_ada()[col0 + col];
        unsafeAtomicAdd(F.MOD() + b * 3072 + col0 + col, s); }
    __syncthreads();
}

struct ColGrp { int base, nvalid, perm; };
__device__ __forceinline__ ColGrp win_group(int G) {
    const int pn = G >> 3, gi = G & 7, bj = gi >> 2, wc = gi & 3; ColGrp g; g.nvalid = 32; g.perm = 0; g.base = 0;
    if (pn < 2) g.base = 0 + 256 * pn + 32 * gi;
    else if (pn < 4) g.base = 512 + 256 * (pn - 2) + 32 * gi;
    else if (pn < 6) { g.base = 1024 + (4 * (pn - 4) + wc) * 64 + 32 * bj; g.perm = (bj == 0); }
    else if (pn == 6) {
        if (wc == 0) { g.base = 1536 + 32 * bj; g.perm = (bj == 0); }
        else if (wc == 1) g.base = 1600 + 32 * bj;
        else if (wc == 2) { g.base = 2688 + 32 * bj; g.perm = (bj == 0); }
        else { g.base = 2752; g.nvalid = bj == 0 ? 8 : 0; }
    }
    else if (pn < 9) g.base = 1664 + 256 * (pn - 7) + 32 * gi;
    else if (pn < 11) { g.base = 2176 + (4 * (pn - 9) + wc) * 64 + 32 * bj; g.perm = (bj == 0); }
    else if (pn < 15) g.base = 2760 + 256 * (pn - 11) + 32 * gi;
    else g.base = 3784 + 256 * (pn - 15) + 32 * gi;
    return g;
}
__device__ __forceinline__ int sigma16(int p) { return p < 16 ? 4 * (p >> 3) + 8 * ((p >> 2) & 1) + (p & 3) : p; }

__device__ __forceinline__ void transpose_item(const float* W, int ldw, int k0, ColGrp g, bf16_t* WT, int ldk, int dst_row0, int dst_k0, LAS float* scr, int lane) {
#pragma unroll 8
    for (int i = 0; i < 32; ++i) { const int kk = 2 * i + (lane >> 5), n = lane & 31; scr[kk * 33 + n] = (n < g.nvalid) ? W[(size_t)(k0 + kk) * ldw + g.base + n] : 0.f; }
    asm volatile("s_waitcnt lgkmcnt(0)" ::: "memory");
    const int c = lane & 7;
#pragma unroll
    for (int j = 0; j < 4; ++j) { const int n = (lane >> 3) + 8 * j; const int sn = g.perm ? sigma16(n) : n; const LAS float* s = scr + (8 * c) * 33 + sn;
        u32x4 o; o.x = cvt_pk_bf16(s[0 * 33], s[1 * 33]); o.y = cvt_pk_bf16(s[2 * 33], s[3 * 33]); o.z = cvt_pk_bf16(s[4 * 33], s[5 * 33]); o.w = cvt_pk_bf16(s[6 * 33], s[7 * 33]);
        *(u32x4*)(WT + (size_t)(dst_row0 + n) * ldk + dst_k0 + 8 * c) = o; }
    asm volatile("s_waitcnt lgkmcnt(0)" ::: "memory");
}
__device__ __forceinline__ void p0_weights(Frame& F) {
    LAS float* scr = (LAS float*)(F.lds + F.wave * 8704);
    const int gw = F.vcu * NWAVES + F.wave, NGW = F.G * NWAVES;
    constexpr int I_IN = 16 * 152, I_A = 8 * 32, I_B = 8 * 32, I_OUT = 16 * 32, I_PG = 2 * 4 * 8, NITEMS = I_IN + I_A + I_B + I_OUT + I_PG;
    for (int it = gw; it < NITEMS; it += NGW) {
        int r = it;
        if (r < I_IN) { const int kb = r / 152, G = r % 152; transpose_item(F.w_in(), 4808, 64 * kb, win_group(G), F.WIN(), 1024, 32 * G, 64 * kb, scr, F.lane); continue; } r -= I_IN;
        if (r < I_A) { const int kb = r / 32, G = r % 32; ColGrp g{32 * G, 32, 0}; transpose_item(F.w_a(), 1024, 64 * kb, g, F.WA(), 512, 32 * G, 64 * kb, scr, F.lane); continue; } r -= I_A;
        if (r < I_B) { const int kb = r / 32, G = r % 32; ColGrp g{32 * G, 32, 0}; transpose_item(F.w_b(), 1024, 64 * kb, g, F.WB(), 512, 32 * G, 64 * kb, scr, F.lane); continue; } r -= I_B;
        if (r < I_OUT) { const int kb = r / 32, G = r % 32; ColGrp g{32 * G, 32, 0}; transpose_item(F.w_out(), 1024, 64 * kb, g, F.WOUT(), 1024, 32 * G, 64 * kb, scr, F.lane); continue; } r -= I_OUT;
        { const int p = r >> 5, kb = (r >> 3) & 3, G8 = r & 7; const int n0 = 32 * G8, gl = n0 >> 7, kd = 64 * kb, gk = kd >> 7;
          ColGrp g{n0 & 127, gl == gk ? 32 : 0, 0};
          transpose_item(F.wpg() + (size_t)(2 * p + gl) * 16384, 128, kd & 127, g, F.WPG() + (size_t)p * 65536, 256, n0, kd, scr, F.lane); }
    }
}

__device__ __forceinline__ void p1_rows(Frame& F) {
    const int gw = F.vcu * NWAVES + F.wave, NGW = F.G * NWAVES;
    for (int task = gw; task < MROWS / 32; task += NGW) {
        const int r0 = task * 32, b = r0 / SEQ;
        const float* md = F.MOD() + b * 3072;
        f32x4 gp[4], sh[4];
#pragma unroll
        for (int j = 0; j < 4; ++j) { const int k = 4 * F.lane + 256 * j; const f32x4 g = *(const f32x4*)(F.gain() + k), s = *(const f32x4*)(md + 1024 + k); gp[j] = g * (1.0f + s); sh[j] = *(const f32x4*)(md + k); }
        for (int i = 0; i < 32; i += 2) {
            const f32x4* xa = (const f32x4*)(F.x() + (size_t)(r0 + i) * DMODEL) + F.lane; const f32x4* xb = xa + DMODEL / 4;
            f32x4 va[4], vb[4]; float sa = 0.f, sb = 0.f;
#pragma unroll
            for (int j = 0; j < 4; ++j) { va[j] = xa[64 * j]; vb[j] = xb[64 * j]; }
#pragma unroll
            for (int j = 0; j < 4; ++j) { sa += (va[j].x * va[j].x + va[j].y * va[j].y) + (va[j].z * va[j].z + va[j].w * va[j].w); sb += (vb[j].x * vb[j].x + vb[j].y * vb[j].y) + (vb[j].z * vb[j].z + vb[j].w * vb[j].w); }
            const float ra = rsqrtf(wave_sum(sa) * (1.0f / DMODEL) + EPS), rb = rsqrtf(wave_sum(sb) * (1.0f / DMODEL) + EPS);
            u32x2* oa = (u32x2*)(F.H() + (size_t)(r0 + i) * DMODEL) + F.lane; u32x2* ob = oa + DMODEL / 4;
#pragma unroll
            for (int j = 0; j < 4; ++j) { const f32x4 ha = va[j] * ra * gp[j] + sh[j], hb = vb[j] * rb * gp[j] + sh[j];
                u32x2 wa, wb; wa.x = cvt_pk_bf16(ha.x, ha.y); wa.y = cvt_pk_bf16(ha.z, ha.w); wb.x = cvt_pk_bf16(hb.x, hb.y); wb.y = cvt_pk_bf16(hb.z, hb.w);
                oa[64 * j] = wa; ob[64 * j] = wb; }
        }
    }
}

struct SchedTiles {
    const char* A; const char* B; size_t a_tile, a_pn, b_tile; int nM, nN, G, c;
    __device__ __forceinline__ bool next(int i, pg8::Unit& u) const { const long L = (long)i * G + c; if (L >= (long)nM * nN) return false; pg8::tile_of((int)L, nM, nN, u.pm, u.pn); u.z = 0; return true; }
    __device__ __forceinline__ const char* a_base(const pg8::Unit& u) const { return A + (size_t)u.pm * a_tile + (size_t)u.pn * a_pn; }
    __device__ __forceinline__ const char* b_base(const pg8::Unit& u) const { return B + (size_t)u.pn * b_tile; }
};
struct SchedMerge {
    const char* A0; const char* A1; const char* B0; const char* B1; int G, c, zf;
    __device__ __forceinline__ bool next(int i, pg8::Unit& u) const { const long L = (long)i * G + c; if (L >= 256 * 4) return false; pg8::tile_of((int)L, 256, 4, u.pm, u.pn); u.z = zf; return true; }
    __device__ __forceinline__ const char* a_base(const pg8::Unit& u) const { return (u.z ? A1 : A0) + (size_t)u.pm * (256 * 512 * 2); }
    __device__ __forceinline__ const char* b_base(const pg8::Unit& u) const { return (u.z ? B1 : B0) + (size_t)u.pn * (256 * 512 * 2); }
};

typedef f32x4 AccT[2][2][4][2];
__device__ __forceinline__ u32x4 pack8(const f32x4 a, const f32x4 b) { u32x4 w; w.x = cvt_pk_bf16(a[0], a[1]); w.y = cvt_pk_bf16(a[2], a[3]); w.z = cvt_pk_bf16(b[0], b[1]); w.w = cvt_pk_bf16(b[2], b[3]); return w; }
__device__ __forceinline__ f32x4 silu4(f32x4 v) { return (f32x4){fast_silu(v[0]), fast_silu(v[1]), fast_silu(v[2]), fast_silu(v[3])}; }
__device__ __forceinline__ f32x4 sigm4(f32x4 v) { return (f32x4){fast_sigmoid(v[0]), fast_sigmoid(v[1]), fast_sigmoid(v[2]), fast_sigmoid(v[3])}; }

__device__ __forceinline__ void rope_tab(int pos, const float (&ifr)[4], float (&cs)[4], float (&sn)[4]) {
#pragma unroll
    for (int i = 0; i < 4; ++i) { const float ang = (float)pos * ifr[i]; const float k = rintf(ang * 0.15915494309189535f);
        float r = fmaf(-k, 6.2831854820251465f, ang); r = fmaf(-k, -1.7484556000744487e-07f, r);
        const float rv = r * 0.15915494309189535f; cs[i] = __builtin_amdgcn_cosf(rv); sn[i] = __builtin_amdgcn_sinf(rv); }
}

struct EpiProj {
    static constexpr bool PERM = true;
    const Args* a;
    template <int ACT> __device__ __forceinline__ void plain(const AccT& acc, bf16_t* O, int ld, int colt, int pm, int wr, int wc, int fr, int fq) const {
        const int row0 = pm * 256 + wr * 64 + fr, col0 = colt + wc * 32 + 8 * fq;
#pragma unroll
        for (int ai = 0; ai < 2; ++ai)
#pragma unroll
            for (int m = 0; m < 4; ++m) { bf16_t* rowp = O + (size_t)(row0 + ai * 128 + m * 16) * ld + col0;
#pragma unroll
                for (int bj = 0; bj < 2; ++bj) { f32x4 v0 = acc[ai][bj][m][0], v1 = acc[ai][bj][m][1];
                    if (ACT == 1) { v0 = silu4(v0); v1 = silu4(v1); } if (ACT == 2) { v0 = sigm4(v0); v1 = sigm4(v1); }
                    *(u32x4*)(rowp + bj * 128) = pack8(v0, v1); }
                asm volatile("" ::: "memory"); }
    }
    template <bool NORM, bool F16> __device__ __forceinline__ void head(const AccT& acc, void* O, int ld, int colh, const float* gain, float oscale, int pm, int wr, int fr, int fq) const {
        const int row0 = pm * 256 + wr * 64 + fr;
        float gp[2][2][4];
#pragma unroll
        for (int bj = 0; bj < 2; ++bj)
#pragma unroll
            for (int n = 0; n < 2; ++n)
#pragma unroll
                for (int i = 0; i < 4; ++i) { const int dim = bj == 0 ? (fq < 2 ? 4 * fq + 8 * n + i : 8 * fq + 4 * n + i) : 32 + 8 * fq + 4 * n + i; gp[bj][n][i] = NORM ? gain[dim] * oscale : oscale; }
        float ifr[4];
#pragma unroll
        for (int i = 0; i < 4; ++i) ifr[i] = exp2f(-(float)(4 * (fq & 1) + i) * (18.931568569324174f / 8.0f));
#pragma unroll
        for (int ai = 0; ai < 2; ++ai)
#pragma unroll
            for (int m = 0; m < 4; ++m) { const int row = row0 + ai * 128 + m * 16;
                f32x4 v[2][2];
#pragma unroll
                for (int bj = 0; bj < 2; ++bj)
#pragma unroll
                    for (int n = 0; n < 2; ++n) v[bj][n] = acc[ai][bj][m][n];
                float rinv = 1.0f;
                if (NORM) { float ss = 0.f;
#pragma unroll
                    for (int bj = 0; bj < 2; ++bj)
#pragma unroll
                        for (int n = 0; n < 2; ++n) ss += (v[bj][n][0] * v[bj][n][0] + v[bj][n][1] * v[bj][n][1]) + (v[bj][n][2] * v[bj][n][2] + v[bj][n][3] * v[bj][n][3]);
                    ss += __shfl_xor(ss, 16); ss += __shfl_xor(ss, 32); rinv = rsqrtf(ss * (1.0f / 64.0f) + EPS); }
#pragma unroll
                for (int bj = 0; bj < 2; ++bj)
#pragma unroll
                    for (int n = 0; n < 2; ++n)
#pragma unroll
                        for (int i = 0; i < 4; ++i) v[bj][n][i] = v[bj][n][i] * rinv * gp[bj][n][i];
                float cs[4], sn[4]; rope_tab(((const int*)a->in[2])[row], ifr, cs, sn);
                if (fq < 2) {
#pragma unroll
                    for (int i = 0; i < 4; ++i) { const float x1 = v[0][0][i], x2 = v[0][1][i]; v[0][0][i] = x1 * cs[i] - x2 * sn[i]; v[0][1][i] = x2 * cs[i] + x1 * sn[i]; } }
#pragma unroll
                for (int bj = 0; bj < 2; ++bj) { u32x4 w;
                    if (F16) { w.x = pk_f16(v[bj][0][0], v[bj][0][1]); w.y = pk_f16(v[bj][0][2], v[bj][0][3]); w.z = pk_f16(v[bj][1][0], v[bj][1][1]); w.w = pk_f16(v[bj][1][2], v[bj][1][3]); }
                    else w = pack8(v[bj][0], v[bj][1]);
                    *(u32x4*)((unsigned short*)O + (size_t)row * ld + colh + 32 * bj + 8 * fq) = w; }
                asm volatile("" ::: "memory"); }
    }
    __device__ __forceinline__ void operator()(const AccT& acc, const pg8::Unit& u, int wr, int wc, int fr, int fq) const {
        asm volatile("" : "+v"(fr), "+v"(fq));
        const int pn = u.pn, pm = u.pm; unsigned char* ws = a->ws;
        if (pn < 2) plain<0>(acc, (bf16_t*)(ws + WS_UA), 512, 256 * pn, pm, wr, wc, fr, fq);
        else if (pn < 4) plain<1>(acc, (bf16_t*)(ws + WS_ZA), 512, 256 * (pn - 2), pm, wr, wc, fr, fq);
        else if (pn < 6) head<true, false>(acc, ws + WS_Q, 512, (4 * (pn - 4) + wc) * 64, (const float*)a->in[9], C2, pm, wr, fr, fq);
        else if (pn == 6) {
            if (wc == 0) head<true, false>(acc, ws + WS_K, 64, 0, (const float*)a->in[10], 1.0f, pm, wr, fr, fq);
            else if (wc == 1) {
                const int row0 = pm * 256 + wr * 64 + fr; bf16_t* VB = (bf16_t*)(ws + WS_V);
#pragma unroll
                for (int ai = 0; ai < 2; ++ai)
#pragma unroll
                    for (int m = 0; m < 4; ++m)
#pragma unroll
                        for (int bj = 0; bj < 2; ++bj) *(u32x4*)(VB + (size_t)(row0 + ai * 128 + m * 16) * 64 + 32 * bj + 8 * fq) = pack8(acc[ai][bj][m][0], acc[ai][bj][m][1]);
            }
            else if (wc == 2) head<false, true>(acc, ws + WS_KI, 64, 0, nullptr, 1.0f, pm, wr, fr, fq);
            else { if (fq == 0) { const int row0 = pm * 256 + wr * 64 + fr; const float wsc = 0.35355339059327373f * 0.125f; float* WI = (float*)(ws + WS_WI);
#pragma unroll
                for (int ai = 0; ai < 2; ++ai)
#pragma unroll
                    for (int m = 0; m < 4; ++m) { float* wp = WI + (size_t)(row0 + ai * 128 + m * 16) * 8; *(f32x4*)wp = acc[ai][0][m][0] * wsc; *(f32x4*)(wp + 4) = acc[ai][0][m][1] * wsc; } } }
        }
        else if (pn < 9) plain<1>(acc, (bf16_t*)(ws + WS_ZB), 512, 256 * (pn - 7), pm, wr, wc, fr, fq);
        else if (pn < 11) head<false, true>(acc, ws + WS_QI, 512, (4 * (pn - 9) + wc) * 64, nullptr, 1.0f, pm, wr, fr, fq);
        else if (pn < 15) plain<2>(acc, (bf16_t*)(ws + WS_GA), 1024, 256 * (pn - 11), pm, wr, wc, fr, fq);
        else plain<2>(acc, (bf16_t*)(ws + WS_GB), 1024, 256 * (pn - 15), pm, wr, wc, fr, fq);
    }
};

struct EpiMix {
    static constexpr bool PERM = true;
    bf16_t* YA; const bf16_t* ZA; const float* pscale;
    __device__ __forceinline__ void operator()(const AccT& acc, const pg8::Unit& u, int wr, int wc, int fr, int fq) const {
        asm volatile("" : "+v"(fr), "+v"(fq));
        const int row0 = u.pm * 256 + wr * 64 + fr, col0 = u.pn * 256 + wc * 32 + 8 * fq;
        f32x4 ps[2][2];
#pragma unroll
        for (int bj = 0; bj < 2; ++bj) { ps[bj][0] = *(const f32x4*)(pscale + col0 + bj * 128); ps[bj][1] = *(const f32x4*)(pscale + col0 + bj * 128 + 4); }
#pragma unroll
        for (int ai = 0; ai < 2; ++ai)
#pragma unroll
            for (int m = 0; m < 4; ++m) { const size_t off = (size_t)(row0 + ai * 128 + m * 16) * 512 + col0;
#pragma unroll
                for (int bj = 0; bj < 2; ++bj) { const u32x4 z = *(const u32x4*)(ZA + off + bj * 128);
                    f32x4 v0 = acc[ai][bj][m][0] * ps[bj][0], v1 = acc[ai][bj][m][1] * ps[bj][1];
                    v0 = v0 * (f32x4){bf_lo(z.x), bf_hi(z.x), bf_lo(z.y), bf_hi(z.y)}; v1 = v1 * (f32x4){bf_lo(z.z), bf_hi(z.z), bf_lo(z.w), bf_hi(z.w)};
                    *(u32x4*)(YA + off + bj * 128) = pack8(v0, v1); }
                asm volatile("" ::: "memory"); }
    }
};
struct EpiMerge {
    static constexpr bool PERM = true;
    bf16_t* MG; const bf16_t* GA; const bf16_t* GB;
    __device__ __forceinline__ void operator()(const AccT& acc, const pg8::Unit& u, int wr, int wc, int fr, int fq) const {
        asm volatile("" : "+v"(fr), "+v"(fq));
        const int row0 = u.pm * 256 + wr * 64 + fr, col0 = u.pn * 256 + wc * 32 + 8 * fq; const bf16_t* Gt = u.z ? GB : GA;
#pragma unroll
        for (int ai = 0; ai < 2; ++ai)
#pragma unroll
            for (int m = 0; m < 4; ++m) { const size_t off = (size_t)(row0 + ai * 128 + m * 16) * 1024 + col0;
#pragma unroll
                for (int bj = 0; bj < 2; ++bj) { const u32x4 g = *(const u32x4*)(Gt + off + bj * 128);
                    f32x4 v0 = acc[ai][bj][m][0] * (f32x4){bf_lo(g.x), bf_hi(g.x), bf_lo(g.y), bf_hi(g.y)}, v1 = acc[ai][bj][m][1] * (f32x4){bf_lo(g.z), bf_hi(g.z), bf_lo(g.w), bf_hi(g.w)};
                    if (u.z) { const u32x4 p = *(const u32x4*)(MG + off + bj * 128); v0 = v0 + (f32x4){bf_lo(p.x), bf_hi(p.x), bf_lo(p.y), bf_hi(p.y)}; v1 = v1 + (f32x4){bf_lo(p.z), bf_hi(p.z), bf_lo(p.w), bf_hi(p.w)}; }
                    *(u32x4*)(MG + off + bj * 128) = pack8(v0, v1); }
                asm volatile("" ::: "memory"); }
    }
};
struct EpiOut {
    static constexpr bool PERM = false;
    const float* x; float* out; const float* MOD;
    __device__ __forceinline__ void operator()(const AccT& acc, const pg8::Unit& u, int wr, int wc, int fr, int fq) const {
        asm volatile("" : "+v"(fr), "+v"(fq));
        const int row0 = u.pm * 256 + wr * 64 + fr, col0 = u.pn * 256 + wc * 32 + 4 * fq; const int b = (u.pm * 256) / SEQ;
        f32x4 gt[2][2];
#pragma unroll
        for (int bj = 0; bj < 2; ++bj)
#pragma unroll
            for (int n = 0; n < 2; ++n) gt[bj][n] = *(const f32x4*)(MOD + b * 3072 + 2048 + col0 + bj * 128 + n * 16);
#pragma unroll
        for (int ai = 0; ai < 2; ++ai)
#pragma unroll
            for (int m = 0; m < 4; ++m) { const size_t off = (size_t)(row0 + ai * 128 + m * 16) * 1024 + col0;
#pragma unroll
                for (int bj = 0; bj < 2; ++bj)
#pragma unroll
                    for (int n = 0; n < 2; ++n) { const f32x4 xv = *(const f32x4*)(x + off + bj * 128 + n * 16); *(f32x4*)(out + off + bj * 128 + n * 16) = xv + gt[bj][n] * acc[ai][bj][m][n]; }
                asm volatile("" ::: "memory"); }
    }
};

__device__ __forceinline__ void ld8(const bf16_t* p, float (&v)[8]) { const u32x4 w = *(const u32x4*)p; v[0] = bf_lo(w.x); v[1] = bf_hi(w.x); v[2] = bf_lo(w.y); v[3] = bf_hi(w.y); v[4] = bf_lo(w.z); v[5] = bf_hi(w.z); v[6] = bf_lo(w.w); v[7] = bf_hi(w.w); }
__device__ __forceinline__ void p3_pool(Frame& F) {
    const int gw = F.vcu * NWAVES + F.wave, NGW = F.G * NWAVES;
    const int g = F.lane >> 4, w = 2 << g;
    for (int task = gw; task < MROWS / 32; task += NGW) {
        const int r0 = task * 32, t0 = r0 & (SEQ - 1);
        const bf16_t* up = F.UA() + (size_t)r0 * 512 + 8 * F.lane; bf16_t* pp = F.POOL() + (size_t)r0 * 512 + 8 * F.lane;
        float sum[8];
#pragma unroll
        for (int e = 0; e < 8; ++e) sum[e] = 0.f;
        if (t0 > 0) { for (int j = 1; j < 16; ++j) if (j < w) { float v[8]; ld8(up - (ptrdiff_t)j * 512, v);
#pragma unroll
            for (int e = 0; e < 8; ++e) sum[e] += v[e]; } }
        for (int i = 0; i < 32; ++i) {
            const int t = t0 + i; float cur[8]; ld8(up + (size_t)i * 512, cur);
            const int cnt = (t + 1) < w ? (t + 1) : w; const float rc = 1.0f / (float)cnt;
            float o[8];
#pragma unroll
            for (int e = 0; e < 8; ++e) { sum[e] += cur[e]; o[e] = sum[e] * rc - cur[e]; }
            u32x4 ow; ow.x = cvt_pk_bf16(o[0], o[1]); ow.y = cvt_pk_bf16(o[2], o[3]); ow.z = cvt_pk_bf16(o[4], o[5]); ow.w = cvt_pk_bf16(o[6], o[7]);
            *(u32x4*)(pp + (size_t)i * 512) = ow;
            if (t - w + 1 >= 0) { float old[8]; ld8(up + (ptrdiff_t)(i - w + 1) * 512, old);
#pragma unroll
                for (int e = 0; e < 8; ++e) sum[e] -= old[e]; }
        }
    }
}

constexpr int AT_BUF = 0, AT_MASK = 65536, AT_MASK_LD = 66, AT_WSF = AT_MASK + 32 * AT_MASK_LD * 4, AT_OST = AT_WSF + NWAVES * 256, AT_END = AT_OST + NWAVES * 4096;
static_assert(AT_END <= RING_BYTES, "attention LDS map");
__device__ __forceinline__ int crow(int r, int hi) { return (r & 3) + 8 * (r >> 2) + 4 * hi; }
__device__ __forceinline__ void glds16(const void* gsrc, LAS unsigned char* dst_uniform) { __builtin_amdgcn_global_load_lds((const unsigned*)gsrc, (LAS unsigned*)dst_uniform, 16, 0, 0); }
__device__ __forceinline__ unsigned half_sum_u32(unsigned v) {
#pragma unroll
    for (int o = 1; o < 32; o <<= 1) v += (unsigned)__shfl_xor((int)v, o);
    return v;
}
__device__ __forceinline__ float half_max(float v) {
#pragma unroll
    for (int o = 1; o < 32; o <<= 1) v = fmaxf(v, __shfl_xor(v, o));
    return v;
}
__device__ __forceinline__ float half_min(float v) {
#pragma unroll
    for (int o = 1; o < 32; o <<= 1) v = fminf(v, __shfl_xor(v, o));
    return v;
}

#define CNT_GE(cnt, v, thr) asm volatile("v_cmp_ge_f32_e32 vcc, %1, %2\n\tv_addc_co_u32_e32 %0, vcc, 0, %0, vcc" : "+v"(cnt) : "v"(v), "v"(thr) : "vcc")
__device__ __forceinline__ void dsa_unit(Frame& F, int b, int qb, float cshift) {
    LAS unsigned char* lds = F.lds;
    int lane_ = F.lane; asm volatile("" : "+v"(lane_));
    const int lane = lane_, w = F.wave, c32 = lane & 31, hh = lane >> 5;
    const int q0 = 32 * qb, S = q0 + 32; const size_t row0 = (size_t)b * SEQ;
    const int nch = (S + 255) >> 8;
    LAS unsigned* MASK = (LAS unsigned*)(lds + AT_MASK);
    f16x8 af[4];
    { const int r = c32, ahh = (r >> 2) & 1, y = (r >> 4) & 1, head = (r & 3) + 4 * ((r >> 3) & 1), qsel = 2 * ahh + y;
      const _Float16* qip = F.QI() + (row0 + q0 + 4 * w + qsel) * 512 + head * 64 + 8 * hh;
#pragma unroll
      for (int ks = 0; ks < 4; ++ks) af[ks] = *(const f16x8*)(qip + 16 * ks); }
    const int qX = q0 + 4 * w + 2 * hh, qY = qX + 1;
    f32x4 wx0, wx1, wy0, wy1;
    { const float* wip = F.WI() + (row0 + qX) * 8; wx0 = *(const f32x4*)wip; wx1 = *(const f32x4*)(wip + 4); wy0 = *(const f32x4*)(wip + 8); wy1 = *(const f32x4*)(wip + 12); }
    const _Float16* kisrc = F.KI() + (row0 + lane) * 64 + w * 8;
#define KI_DMA(ch) do { const _Float16* p_ = kisrc; asm volatile("" : "+v"(p_));   \
        _Pragma("unroll") for (int g_ = 0; g_ < 4; ++g_) glds16(p_ + (size_t)((ch) * 256 + g_ * 64) * 64, lds + AT_BUF + ((ch) & 1) * 32768 + w * 4096 + g_ * 1024); } while (0)
    float sx[64], sy[64];
    KI_DMA(0);
#pragma unroll
    for (int ch = 0; ch < 8; ++ch) {
        if (ch < nch) {
            asm volatile("s_waitcnt vmcnt(0)" ::: "memory"); __syncthreads();
            if (ch + 1 < nch) KI_DMA(ch + 1);
            const LAS unsigned char* kb = lds + AT_BUF + (ch & 1) * 32768 + hh * 4096 + c32 * 16;
#pragma unroll
            for (int t = 0; t < 8; ++t) {
                const int T = 8 * ch + t;
                if (32 * T < S) {
                    f32x16 acc = {};
#pragma unroll
                    for (int ks = 0; ks < 4; ++ks) { const f16x8 bfr = *(const LAS f16x8*)(kb + ks * 8192 + t * 512); acc = __builtin_amdgcn_mfma_f32_32x32x16_f16(af[ks], bfr, acc, 0, 0, 0); }
                    float ax = 0.f, ay = 0.f;
#pragma unroll
                    for (int j = 0; j < 4; ++j) { ax += fmaxf(acc[j], 0.f) * wx0[j]; ay += fmaxf(acc[8 + j], 0.f) * wy0[j]; }
#pragma unroll
                    for (int j = 0; j < 4; ++j) { ax += fmaxf(acc[4 + j], 0.f) * wx1[j]; ay += fmaxf(acc[12 + j], 0.f) * wy1[j]; }
                    if (T == qb) { ax = c32 <= (qX & 31) ? ax : -INFINITY; ay = c32 <= (qY & 31) ? ay : -INFINITY; }
                    sx[T] = ax; sy[T] = ay;
                } else { sx[T] = -INFINITY; sy[T] = -INFINITY; }
                __builtin_amdgcn_sched_barrier(0);
            }
        } else {
#pragma unroll
            for (int t = 0; t < 8; ++t) { sx[8 * ch + t] = -INFINITY; sy[8 * ch + t] = -INFINITY; }
        }
    }
#undef KI_DMA
    float Tx = -3.0e38f, Ty = -3.0e38f; int needx = 0x7fffffff, needy = 0x7fffffff;
#ifndef NO_SEL
    {
        bool donex = (qX + 1) <= 256, doney = (qY + 1) <= 256;
        float lox, hix = INFINITY, loy, hiy = INFINITY; int chx = 0, chy = 0; float px, py;
        { float mx = -INFINITY, mn = INFINITY, my = -INFINITY, ny = INFINITY;
#pragma unroll
          for (int T = 0; T < 64; ++T) { mx = fmaxf(mx, sx[T]); my = fmaxf(my, sy[T]); mn = fminf(mn, sx[T] == -INFINITY ? INFINITY : sx[T]); ny = fminf(ny, sy[T] == -INFINITY ? INFINITY : sy[T]); }
          px = half_max(mx); py = half_max(my); lox = half_min(mn); loy = half_min(ny); }
        bool first = true;
        while (__any(!(donex && doney))) {
            if (!first) { px = 0.5f * lox + 0.5f * hix; py = 0.5f * loy + 0.5f * hiy; }
            first = false;
            if (!donex && !(px > lox && px < hix)) { donex = true; Tx = lox; needx = 256 - chx; }
            if (!doney && !(py > loy && py < hiy)) { doney = true; Ty = loy; needy = 256 - chy; }
            unsigned cx = 0, cy = 0;
#pragma unroll
            for (int ch = 0; ch < 8; ++ch) if (ch < nch) {
#pragma unroll
                for (int t = 0; t < 8; ++t) { CNT_GE(cx, sx[8 * ch + t], px); CNT_GE(cy, sy[8 * ch + t], py); } }
            const unsigned pk = half_sum_u32(cx | (cy << 16)); cx = pk & 0xffffu; cy = pk >> 16;
            if (!donex) { if (cx == 256u) { donex = true; Tx = px; needx = 0x7fffffff; } else if (cx > 256u) lox = px; else { hix = px; chx = (int)cx; } }
            if (!doney) { if (cy == 256u) { doney = true; Ty = py; needy = 0x7fffffff; } else if (cy > 256u) loy = py; else { hiy = py; chy = (int)cy; } }
        }
    }
#endif
#ifndef NO_MASKW
    {
        int runx = 0, runy = 0; const unsigned below = (1u << c32) - 1u;
#pragma unroll
        for (int T = 0; T < 64; ++T) if (T < 2 * ((qb >> 1) + 1)) {
            const bool gx = sx[T] > Tx, ex = sx[T] == Tx, gy = sy[T] > Ty, ey = sy[T] == Ty;
            const unsigned long long bex = __ballot(ex), bey = __ballot(ey);
            const unsigned mex = hh ? (unsigned)(bex >> 32) : (unsigned)bex, mey = hh ? (unsigned)(bey >> 32) : (unsigned)bey;
            const bool selx = gx || (ex && (runx + (int)__popc(mex & below)) < needx), sely = gy || (ey && (runy + (int)__popc(mey & below)) < needy);
            runx += (int)__popc(mex); runy += (int)__popc(mey);
            const unsigned long long bsx = __ballot(selx), bsy = __ballot(sely);
            if (lane < 4) { const unsigned wd = lane == 0 ? (unsigned)bsx : lane == 1 ? (unsigned)bsy : lane == 2 ? (unsigned)(bsx >> 32) : (unsigned)(bsy >> 32);
                MASK[(4 * w + lane) * AT_MASK_LD + T] = wd; }
        }
    }
#endif
    __syncthreads();
#ifndef NO_P2
    const int NT = (qb >> 1) + 1;
    bf16x8 qr[4];
    { const bf16_t* Qw = F.Q() + (row0 + q0 + c32) * 512 + w * 64 + hh * 8;
#pragma unroll
      for (int d0 = 0; d0 < 4; ++d0) qr[d0] = *(const bf16x8*)(Qw + d0 * 16); }
    const bf16_t* ksrc = F.KB() + (row0 + lane) * 64 + w * 8;
    const bf16_t* vsrc = F.VB() + (row0 + 16 * (w & 3) + (lane >> 2)) * 64 + (w >> 2) * 32 + (lane & 3) * 8;
#define KV_DMA(t) do { glds16(ksrc + (size_t)(t) * 4096, lds + AT_BUF + ((t) & 1) * 16384 + w * 1024); glds16(vsrc + (size_t)(t) * 4096, lds + AT_BUF + ((t) & 1) * 16384 + 8192 + w * 1024); } while (0)
    f32x16 o0 = {}, o1 = {}; float l_reg = 0.f;
    const float negc = -cshift;
    KV_DMA(0);
    for (int t = 0; t < NT; ++t) {
        asm volatile("s_waitcnt vmcnt(0)" ::: "memory"); __syncthreads();
        if (t + 1 < NT) KV_DMA(t + 1);
        const LAS unsigned char* Ks = lds + AT_BUF + (t & 1) * 16384; const LAS unsigned char* Vs = Ks + 8192;
        const u32x2 mw = *(const LAS u32x2*)(MASK + c32 * AT_MASK_LD + 2 * t);
        const unsigned w0 = mw.x >> (4 * hh), w1 = mw.y >> (4 * hh);
        f32x16 p0, p1;
#pragma unroll
        for (int r = 0; r < 16; ++r) { const int bp = (r & 3) + 8 * (r >> 2); p0[r] = ((w0 >> bp) & 1u) ? negc : -INFINITY; p1[r] = ((w1 >> bp) & 1u) ? negc : -INFINITY; }
        { const LAS unsigned char* kb = Ks + hh * 1024 + c32 * 16;
#pragma unroll
          for (int d0 = 0; d0 < 4; ++d0) { const bf16x8 b0 = *(const LAS bf16x8*)(kb + d0 * 2048), b1 = *(const LAS bf16x8*)(kb + d0 * 2048 + 512);
              p0 = __builtin_amdgcn_mfma_f32_32x32x16_bf16(b0, qr[d0], p0, 0, 0, 0); p1 = __builtin_amdgcn_mfma_f32_32x32x16_bf16(b1, qr[d0], p1, 0, 0, 0); } }
        float sacc = 0.f;
#pragma unroll
        for (int r = 0; r < 16; ++r) { p0[r] = __builtin_amdgcn_exp2f(p0[r]); p1[r] = __builtin_amdgcn_exp2f(p1[r]); sacc += p0[r] + p1[r]; }
        l_reg += sacc;
        bf16x8 pa[4];
        { u32x4 pw0, pw1, pw2, pw3;
          pw0 = (u32x4){cvt_pk_bf16(p0[0], p0[1]), cvt_pk_bf16(p0[2], p0[3]), cvt_pk_bf16(p0[4], p0[5]), cvt_pk_bf16(p0[6], p0[7])};
          pw1 = (u32x4){cvt_pk_bf16(p0[8], p0[9]), cvt_pk_bf16(p0[10], p0[11]), cvt_pk_bf16(p0[12], p0[13]), cvt_pk_bf16(p0[14], p0[15])};
          pw2 = (u32x4){cvt_pk_bf16(p1[0], p1[1]), cvt_pk_bf16(p1[2], p1[3]), cvt_pk_bf16(p1[4], p1[5]), cvt_pk_bf16(p1[6], p1[7])};
          pw3 = (u32x4){cvt_pk_bf16(p1[8], p1[9]), cvt_pk_bf16(p1[10], p1[11]), cvt_pk_bf16(p1[12], p1[13]), cvt_pk_bf16(p1[14], p1[15])};
          pa[0] = __builtin_bit_cast(bf16x8, pw0); pa[1] = __builtin_bit_cast(bf16x8, pw1); pa[2] = __builtin_bit_cast(bf16x8, pw2); pa[3] = __builtin_bit_cast(bf16x8, pw3); }
        { const LAS unsigned char* vb = Vs + ((lane >> 4) & 1) * 32 + (lane & 3) * 8 + (4 * hh + ((lane & 15) >> 2)) * 64;
#pragma unroll
          for (int d0 = 0; d0 < 2; ++d0) {
#pragma unroll
              for (int ks = 0; ks < 4; ++ks) {
                  const s16x4 lo = __builtin_bit_cast(s16x4, __builtin_amdgcn_ds_read_tr16_b64_v4i16((LAS s16x4*)(vb + d0 * 4096 + ks * 1024)));
                  const s16x4 hi = __builtin_bit_cast(s16x4, __builtin_amdgcn_ds_read_tr16_b64_v4i16((LAS s16x4*)(vb + d0 * 4096 + ks * 1024 + 512)));
                  const bf16x8 vf = (bf16x8){lo[0], lo[1], lo[2], lo[3], hi[0], hi[1], hi[2], hi[3]};
                  if (d0 == 0) o0 = __builtin_amdgcn_mfma_f32_32x32x16_bf16(pa[ks], vf, o0, 0, 0, 0); else o1 = __builtin_amdgcn_mfma_f32_32x32x16_bf16(pa[ks], vf, o1, 0, 0, 0); } } }
    }
#undef KV_DMA
    { auto rr = __builtin_amdgcn_permlane32_swap(__float_as_uint(l_reg), __float_as_uint(l_reg), false, false); l_reg = __uint_as_float(rr[0]) + __uint_as_float(rr[1]); }
    LAS float* wsf = (LAS float*)(lds + AT_WSF) + w * 64;
    if (hh == 0) wsf[c32] = l_reg;
    asm volatile("s_waitcnt lgkmcnt(0)" ::: "memory");
    LAS bf16_t* stg = (LAS bf16_t*)(lds + AT_OST) + w * 2048;
#pragma unroll
    for (int r = 0; r < 16; ++r) { const int orow = crow(r, hh); const float rl = __builtin_amdgcn_rcpf(wsf[orow]);
        stg[orow * 64 + c32] = (bf16_t)(cvt_pk_bf16(o0[r] * rl, 0.f) & 0xffffu); stg[orow * 64 + 32 + c32] = (bf16_t)(cvt_pk_bf16(o1[r] * rl, 0.f) & 0xffffu); }
    asm volatile("s_waitcnt lgkmcnt(0)" ::: "memory");
#pragma unroll
    for (int i = 0; i < 4; ++i) { const int row = i * 8 + (lane >> 3), chn = lane & 7; const u32x4 ov = *(const LAS u32x4*)(stg + row * 64 + chn * 8);
        const size_t go = (row0 + q0 + row) * 512 + w * 64 + chn * 8; const u32x4 z = *(const u32x4*)(F.ZB() + go);
        u32x4 y; y.x = cvt_pk_bf16(bf_lo(ov.x) * bf_lo(z.x), bf_hi(ov.x) * bf_hi(z.x)); y.y = cvt_pk_bf16(bf_lo(ov.y) * bf_lo(z.y), bf_hi(ov.y) * bf_hi(z.y));
        y.z = cvt_pk_bf16(bf_lo(ov.z) * bf_lo(z.z), bf_hi(ov.z) * bf_hi(z.z)); y.w = cvt_pk_bf16(bf_lo(ov.w) * bf_lo(z.w), bf_hi(ov.w) * bf_hi(z.w));
        *(u32x4*)(F.Q() + go) = y; }
#endif
    asm volatile("s_waitcnt lgkmcnt(0)" ::: "memory"); __syncthreads();
}

__device__ __forceinline__ void p3_dsa(Frame& F) {
    float gq = F.lane < 64 ? fabsf(F.qg()[F.lane]) : 0.f, gk = fabsf(F.kg()[F.lane]);
#pragma unroll
    for (int o = 1; o < 64; o <<= 1) { gq = fmaxf(gq, __shfl_xor(gq, o)); gk = fmaxf(gk, __shfl_xor(gk, o)); }
    const float cshift = 8.0f * LOG2E * gq * gk * 1.02f;
    const int b = F.vcu >> 3, s = F.vcu & 7;
    if (F.G == 256) {
        for (int i = 7; i >= 0; --i) { const int qb = (i & 1) ? 16 * (i >> 1) + 15 - s : 16 * (i >> 1) + s; dsa_unit(F, b, qb, cshift); }
    } else {
        for (int u = blockIdx.x; u < BATCH * 64; u += F.G) dsa_unit(F, u >> 6, u & 63, cshift);
    }
}

#ifndef SLOW_MASK
#define SLOW_MASK 0
#endif
__global__ void __launch_bounds__(NTHREADS, 2) mk_fwd(Args args) {
    extern __shared__ __attribute__((aligned(16))) unsigned char lds_raw[];
    cg::grid_group grid = cg::this_grid();
    Frame F;
    F.lds = (LAS unsigned char*)lds_raw;
    F.tid = threadIdx.x; F.lane = F.tid & 63; F.wave = __builtin_amdgcn_readfirstlane(F.tid >> 6);
    F.G = gridDim.x; { const int bx = blockIdx.x; F.vcu = (F.G % 8 == 0) ? (bx % 8) * (F.G / 8) + bx / 8 : bx; }
    F.a = &args;
    const int lo = args.ph_lo, hi = args.ph_hi;
#ifndef PH_MASK
#define PH_MASK 0xff
#endif
#define IN(k) (((PH_MASK >> (k)) & 1) && lo <= (k) && (k) < hi)
#define SEAM(k) do { if (IN(k) && IN((k) + 1)) grid.sync(); } while (0)
    if (IN(0)) { p0_mod(F); p0_weights(F); } SEAM(0);
    if (IN(1)) { p1_rows(F); } SEAM(1);
    if (IN(2)) {
        SchedTiles S{(const char*)F.H(), (const char*)F.WIN(), (size_t)256 * 1024 * 2, 0, (size_t)256 * 1024 * 2, 256, 19, F.G, (int)blockIdx.x};
        EpiProj E{F.a};
        if (SLOW_MASK & 4) pg8::slow_gemm_phase<EpiProj, SchedTiles>(F.lds, 1024, 1024, 1024, S, E); else pg8::gemm_phase<EpiProj, SchedTiles>(F.lds, 1024, 1024, 1024, S, E);
    } SEAM(2);
#ifdef DSA_ZERO
    if (IN(3)) { p3_pool(F); u32x4* yz = (u32x4*)F.Q(); for (size_t i = (size_t)blockIdx.x * NTHREADS + F.tid; i < (size_t)MROWS * 512 / 8; i += (size_t)F.G * NTHREADS) yz[i] = (u32x4){0u, 0u, 0u, 0u}; } SEAM(3);
#else
    if (IN(3)) { p3_pool(F); __syncthreads(); p3_dsa(F); } SEAM(3);
#endif
    if (IN(4)) {
        SchedTiles S{(const char*)F.POOL(), (const char*)F.WPG(), (size_t)256 * 512 * 2, (size_t)256 * 2, (size_t)256 * 256 * 2, 256, 2, F.G, (int)blockIdx.x};
        EpiMix E{F.UA()  , F.ZA(), F.pscale()};
        if (SLOW_MASK & 16) pg8::slow_gemm_phase<EpiMix, SchedTiles>(F.lds, 256, 512, 256, S, E); else pg8::gemm_phase<EpiMix, SchedTiles>(F.lds, 256, 512, 256, S, E);
    } SEAM(4);
    if (IN(5)) {
        EpiMerge E{F.H()  , F.GA(), F.GB()};
        SchedMerge S{(const char*)F.UA(), (const char*)F.Q(), (const char*)F.WA(), (const char*)F.WB(), F.G, (int)blockIdx.x, 0};
        if (SLOW_MASK & 32) pg8::slow_gemm_phase<EpiMerge, SchedMerge>(F.lds, 512, 512, 512, S, E); else pg8::gemm_phase<EpiMerge, SchedMerge>(F.lds, 512, 512, 512, S, E);
    } SEAM(5);
    if (IN(6)) {
        EpiMerge E{F.H(), F.GA(), F.GB()};
        SchedMerge S{(const char*)F.UA(), (const char*)F.Q(), (const char*)F.WA(), (const char*)F.WB(), F.G, (int)blockIdx.x, 1};
        if (SLOW_MASK & 32) pg8::slow_gemm_phase<EpiMerge, SchedMerge>(F.lds, 512, 512, 512, S, E); else pg8::gemm_phase<EpiMerge, SchedMerge>(F.lds, 512, 512, 512, S, E);
    } SEAM(6);
    if (IN(7)) {
        SchedTiles S{(const char*)F.H(), (const char*)F.WOUT(), (size_t)256 * 1024 * 2, 0, (size_t)256 * 1024 * 2, 256, 4, F.G, (int)blockIdx.x};
        EpiOut E{F.x(), F.out(), F.MOD()};
        if (SLOW_MASK & 64) pg8::slow_gemm_phase<EpiOut, SchedTiles>(F.lds, 1024, 1024, 1024, S, E); else pg8::gemm_phase<EpiOut, SchedTiles>(F.lds, 1024, 1024, 1024, S, E);
    }
#undef IN
#undef SEAM
}


#ifdef DIAG
#ifndef DIAG_B
#define DIAG_B 5
#endif
#ifndef DIAG_ONLY
#define DIAG_ONLY -1
#endif
extern "C" void kernel_launch(void* const* d_in, const int* in_sizes, int n_in, void* d_out, int out_size, void* d_ws, size_t ws_size, hipStream_t stream) {
    static int grid = 0;
    if (grid == 0) { int dev = 0, cus = 0; hipGetDevice(&dev); hipDeviceGetAttribute(&cus, hipDeviceAttributeMultiprocessorCount, dev);
        hipFuncSetAttribute((const void*)mk_fwd, hipFuncAttributeMaxDynamicSharedMemorySize, LDS_BYTES); grid = cus; }
    (void)hipMemsetAsync((char*)d_ws + WS_CTL, 0, CTL_ZERO_BYTES, stream);
    unsigned char* ws = (unsigned char*)d_ws; float* out = (float*)d_out;
    unsigned* res = (unsigned*)(ws + 512 * 1024);
    const nv::Bufs G = nv::carve(ws + 840 * MiB); float* gout = (float*)(ws + 960 * MiB); const int b = DIAG_B;
    nv::run_mod(d_in, G, stream); nv::run_batch(d_in, out, G, b, stream);
    dg::copy_f<<<SEQ * 1024 / 256, 256, 0, stream>>>(out + (size_t)b * SEQ * 1024, gout, (long)SEQ * 1024);
    Args a{}; for (int i = 0; i < 14; ++i) a.in[i] = d_in[i]; a.out = out; a.ws = ws;
    auto phase = [&](int p) { a.ph_lo = p; a.ph_hi = p + 1; hipLaunchKernelGGL(mk_fwd, dim3(grid), dim3(NTHREADS), LDS_BYTES, stream, a); };
    auto check = [&](int kind, long n) { dg::chk<<<(unsigned)((n + 255) / 256), 256, 0, stream>>>(kind, b, ws, out, G, gout, res, n); };
    const long R = SEQ;
    phase(0); phase(1); phase(2);
    check(0, 32 * 3072); check(1, R * 1024); check(2, R * 512); check(3, R * 512); check(4, R * 512); check(5, R * 64); check(6, R * 64); check(7, R * 512);
    check(8, R * 512); check(9, R * 64); check(10, R * 8); check(11, R * 1024); check(12, R * 1024);
    phase(3); check(13, R * 512); check(15, R * 512);
    phase(4); check(14, R * 512);
    phase(5); check(16, R * 1024);
    phase(6); check(17, R * 1024);
    phase(7); check(18, R * 1024);
    nv::run(d_in, out, ws + 840 * MiB, stream);
    dg::encode<<<1, 64, 0, stream>>>(res, out, DIAG_ONLY);
}
#else
#ifndef MK_N_LAUNCHES
#define MK_N_LAUNCHES 1
#endif
extern "C" void kernel_launch(void* const* d_in, const int* in_sizes, int n_in, void* d_out, int out_size, void* d_ws, size_t ws_size, hipStream_t stream) {
    static int grid = 0;
    if (grid == 0) {
        int dev = 0, cus = 0, per_cu = 0;
        if (hipGetDevice(&dev) != hipSuccess || hipDeviceGetAttribute(&cus, hipDeviceAttributeMultiprocessorCount, dev) != hipSuccess) { fprintf(stderr, "kernel_launch: device query failed\n"); grid = -1; return; }
        if (hipFuncSetAttribute((const void*)mk_fwd, hipFuncAttributeMaxDynamicSharedMemorySize, LDS_BYTES) != hipSuccess) { fprintf(stderr, "kernel_launch: hipFuncSetAttribute failed\n"); grid = -1; return; }
        if (hipOccupancyMaxActiveBlocksPerMultiprocessor(&per_cu, (const void*)mk_fwd, NTHREADS, LDS_BYTES) != hipSuccess || per_cu < 1) { fprintf(stderr, "kernel_launch: occupancy query says %d blocks per CU\n", per_cu); grid = -1; return; }
        grid = cus * 1;
        if (n_in != 14 || ws_size < WS_END) { fprintf(stderr, "kernel_launch: unexpected inputs (%d) or workspace (%zu)\n", n_in, ws_size); grid = -1; return; }
    }
    if (grid < 0) return;
    (void)hipMemsetAsync((char*)d_ws + WS_CTL, 0, CTL_ZERO_BYTES, stream);
    Args a{};
    for (int i = 0; i < 14; ++i) a.in[i] = d_in[i];
    a.out = (float*)d_out; a.ws = (unsigned char*)d_ws;
#if MK_N_LAUNCHES == 1
    a.ph_lo = 0; a.ph_hi = 8;
    void* kargs[] = {&a};
    const hipError_t e = hipLaunchCooperativeKernel((const void*)mk_fwd, dim3(grid), dim3(NTHREADS), kargs, LDS_BYTES, stream);
    if (e != hipSuccess) fprintf(stderr, "kernel_launch: cooperative launch failed: %s (grid %d)\n", hipGetErrorString(e), grid);
#else
    for (int p = 0; p < 8; ++p) { a.ph_lo = p; a.ph_hi = p + 1; hipLaunchKernelGGL(mk_fwd, dim3(grid), dim3(NTHREADS), LDS_BYTES, stream, a); }
#endif
}
#endif
```

```cpp
#include <hip/hip_runtime.h>
#include <hip/hip_cooperative_groups.h>
#include <cstdio>
#include <cstdint>
#include <cmath>
namespace cg = cooperative_groups;

#define LAS __attribute__((address_space(3)))
typedef unsigned short bf16_t;
typedef short bf16x8 __attribute__((ext_vector_type(8)));
typedef _Float16 f16x8 __attribute__((ext_vector_type(8)));
typedef float f32x2 __attribute__((ext_vector_type(2)));
typedef float f32x4 __attribute__((ext_vector_type(4)));
typedef float f32x16 __attribute__((ext_vector_type(16)));
typedef unsigned u32x2 __attribute__((ext_vector_type(2)));
typedef unsigned u32x4 __attribute__((ext_vector_type(4)));
typedef short s16x4 __attribute__((ext_vector_type(4)));

constexpr int BATCH = 32, SEQ = 2048, DMODEL = 1024, MROWS = BATCH * SEQ, NPROJ = 4864  ;
constexpr float EPS = 1e-6f;
constexpr float LOG2E = 1.4426950408889634f;
constexpr float C2 = 0.125f * LOG2E;

constexpr size_t MiB = 1u << 20;
constexpr size_t WS_CTL = 0, CTL_ZERO_BYTES = 1 * MiB;
constexpr size_t WS_MOD = 64 * 1024;
constexpr size_t WS_WIN = 2 * MiB, WS_WPG = 12 * MiB, WS_WA = 13 * MiB, WS_WB = 14 * MiB, WS_WOUT = 15 * MiB;
constexpr size_t WS_K = 18 * MiB, WS_V = 26 * MiB, WS_KI = 34 * MiB, WS_WI = 42 * MiB;
constexpr size_t WS_H = 64 * MiB;
constexpr size_t WS_UA = 192 * MiB;
constexpr size_t WS_POOL = 256 * MiB, WS_ZA = 320 * MiB, WS_Q = 384 * MiB  , WS_ZB = 448 * MiB, WS_QI = 512 * MiB;
constexpr size_t WS_GA = 576 * MiB, WS_GB = 704 * MiB, WS_YB = 832 * MiB, WS_END = 896 * MiB;

constexpr int NWAVES = 8, NTHREADS = 512;
constexpr int RING_BYTES = 131072, LDS_BYTES = 147456;

__device__ __forceinline__ float wave_sum(float v) {
#pragma unroll
    for (int o = 1; o < 64; o <<= 1) v += __shfl_xor(v, o);
    return v;
}
typedef __bf16 bf16x2_t __attribute__((ext_vector_type(2)));
__device__ __forceinline__ unsigned cvt_pk_bf16(float lo, float hi) { const f32x2 v = {lo, hi}; const bf16x2_t b = __builtin_convertvector(v, bf16x2_t); return __builtin_bit_cast(unsigned, b); }
__device__ __forceinline__ unsigned pk_f16(float lo, float hi) { const _Float16 a = (_Float16)lo, b = (_Float16)hi; return (unsigned)__builtin_bit_cast(unsigned short, a) | ((unsigned)__builtin_bit_cast(unsigned short, b) << 16); }
__device__ __forceinline__ float bf_lo(unsigned w) { return __uint_as_float(w << 16); }
__device__ __forceinline__ float bf_hi(unsigned w) { return __uint_as_float(w & 0xffff0000u); }
__device__ __forceinline__ float fast_sigmoid(float v) { return __builtin_amdgcn_rcpf(1.0f + __builtin_amdgcn_exp2f(-LOG2E * v)); }
__device__ __forceinline__ float fast_silu(float v) { return v * fast_sigmoid(v); }

namespace pg8 {
constexpr int BM = 256, BK = 64, HALF = 128, HTB = HALF * BK * 2, STAGE_BYTES = 8 * HTB, NXCD = 8, WGM = 8;
__host__ __device__ __forceinline__ int lds_byte(int r, int c) { const int st = (r >> 4) * 2 + (c >> 5), rr = r & 15, cc = c & 31, ob = rr * 64 + cc * 2; return st * 1024 + (ob ^ (((ob >> 9) & 1) << 5)); }
__host__ __device__ __forceinline__ void stage_rc(int b, int& R, int& C) { const int st = b / 1024, sb = b % 1024, swz = sb ^ (((sb >> 9) & 1) << 5); R = (st >> 1) * 16 + swz / 64; C = (st & 1) * 32 + (swz % 64) / 2; }
__host__ __device__ __forceinline__ int perm32(int rho) { const int n = rho >> 4, i = rho & 15; return 8 * (i >> 2) + 4 * n + (i & 3); }

struct Unit { int pm, pn, z; };
__device__ __forceinline__ void tile_of(int L, int nM, int nN, int& pm, int& pn) {
    const int nwg = nM * nN; int wgid = L;
    { const int q = nwg / NXCD, r = nwg % NXCD, xcd = wgid % NXCD, off = wgid / NXCD; wgid = (xcd < r ? xcd * (q + 1) : r * (q + 1) + (xcd - r) * q) + off; }
    const int nig = WGM * nN, gid = wgid / nig, fm = gid * WGM, gsz = (nM - fm) < WGM ? (nM - fm) : WGM;
    pm = fm + ((wgid % nig) % gsz); pn = (wgid % nig) / gsz;
}

template <class Epi, class Sched>
__device__ __forceinline__ void gemm_phase(LAS unsigned char* lds, const int K, const int lda, const int ldb, const Sched& S, const Epi& E) {
    const int tid = threadIdx.x, wid = __builtin_amdgcn_readfirstlane(tid >> 6), lane = tid & 63, wr = wid >> 2, wc = wid & 3, fr = lane & 15, fq = lane >> 4;
    int nt = K / BK; asm volatile("" : "+s"(nt));
    unsigned voffA[2], voffB[2];
#pragma unroll
    for (int i = 0; i < 2; ++i) { int R, C; stage_rc(tid * 16 + i * 8192, R, C); const int Rb = Epi::PERM ? ((R & ~31) + perm32(R & 31)) : R;
        voffA[i] = (unsigned)(R * lda + C) * 2u; voffB[i] = (unsigned)(Rb * ldb + C) * 2u; }
    const size_t kstep = (size_t)(BK * 2);
    const size_t hstepA = (size_t)HALF * lda * 2, hstepB = (size_t)HALF * ldb * 2;
    const unsigned ldsw = (unsigned)wid * 1024u;
    const int aoff = lds_byte(wr * 64 + fr, fq * 8), boff = lds_byte(wc * 32 + fr, fq * 8);
#define PG8_SA(b, h) (((b) * 2 + (h)) * HTB)
#define PG8_SB(b, h) ((4 + (b) * 2 + (h)) * HTB)
#define PG8_STAGE(bufoff, gbase, voff) do { _Pragma("unroll") for (int _i = 0; _i < 2; ++_i) \
        __builtin_amdgcn_global_load_lds((const unsigned*)((const char*)(gbase) + (voff)[_i]), (LAS unsigned*)(lds + (bufoff) + ldsw + _i * 8192), 16, 0, 0); } while (0)
#define PG8_LDA(dst, b, h) do { _Pragma("unroll") for (int m = 0; m < 4; ++m) _Pragma("unroll") for (int k = 0; k < 2; ++k) dst[m][k] = *(const LAS bf16x8*)(lds + PG8_SA(b, h) + aoff + m * 2048 + k * 1024); } while (0)
#define PG8_LDB(dst, b, h) do { _Pragma("unroll") for (int n = 0; n < 2; ++n) _Pragma("unroll") for (int k = 0; k < 2; ++k) dst[n][k] = *(const LAS bf16x8*)(lds + PG8_SB(b, h) + boff + n * 2048 + k * 1024); } while (0)
#define PG8_MMA(ai, bj, At, Bt) do { __builtin_amdgcn_s_setprio(1); _Pragma("unroll") for (int m = 0; m < 4; ++m) _Pragma("unroll") for (int n = 0; n < 2; ++n) _Pragma("unroll") for (int k = 0; k < 2; ++k) \
        acc[ai][bj][m][n] = __builtin_amdgcn_mfma_f32_16x16x32_bf16(Bt[n][k], At[m][k], acc[ai][bj][m][n], 0, 0, 0); __builtin_amdgcn_s_setprio(0); } while (0)
#define PG8_WAIT_V(n) asm volatile("s_waitcnt vmcnt(" #n ")" ::: "memory")
#define PG8_WAIT_L(n) asm volatile("s_waitcnt lgkmcnt(" #n ")" ::: "memory")
#define PG8_BAR __builtin_amdgcn_s_barrier()
#define PG8_SCHED __builtin_amdgcn_sched_barrier(0)
    Unit cur, nxt; int ui = 0;
    if (!S.next(0, cur)) return;
    f32x4 acc[2][2][4][2];
#pragma unroll
    for (int a = 0; a < 2; ++a)
#pragma unroll
        for (int b = 0; b < 2; ++b)
#pragma unroll
            for (int m = 0; m < 4; ++m)
#pragma unroll
                for (int n = 0; n < 2; ++n) acc[a][b][m][n] = (f32x4){0.f, 0.f, 0.f, 0.f};
    bf16x8 At[4][2], B0[2][2], B1[2][2];
    const char* cA = S.a_base(cur); const char* cB = S.b_base(cur);
    PG8_STAGE(PG8_SB(0, 0), cB, voffB); PG8_STAGE(PG8_SB(0, 1), cB + hstepB, voffB); PG8_STAGE(PG8_SA(0, 0), cA, voffA); PG8_STAGE(PG8_SA(0, 1), cA + hstepA, voffA);
    if (wr == 1) PG8_BAR;
    PG8_WAIT_V(2); PG8_BAR;
    PG8_STAGE(PG8_SB(1, 0), cB + kstep, voffB); PG8_STAGE(PG8_SA(1, 0), cA + kstep, voffA); PG8_STAGE(PG8_SB(1, 1), cB + hstepB + kstep, voffB);
    PG8_WAIT_V(6); PG8_BAR;
    for (;;) {
        const bool has_next = S.next(ui + 1, nxt);
        const char* nA = has_next ? S.a_base(nxt) : cA; const char* nB = has_next ? S.b_base(nxt) : cB;
        for (int t = 0; t < nt; t += 2) {
            const bool last = (t == nt - 2);
            const char* a1 = cA + (size_t)(t + 1) * kstep;
            const char* a2 = last ? nA : cA + (size_t)(t + 2) * kstep; const char* b2 = last ? nB : cB + (size_t)(t + 2) * kstep;
            const char* a3 = a2 + kstep; const char* b3 = b2 + kstep;
            PG8_LDB(B0, 0, 0); PG8_LDB(B1, 0, 1); PG8_SCHED; PG8_LDA(At, 0, 0); PG8_STAGE(PG8_SA(1, 1), a1 + hstepA, voffA);
            PG8_WAIT_V(8); PG8_WAIT_L(0); PG8_BAR; PG8_MMA(0, 0, At, B0); PG8_MMA(0, 1, At, B1); PG8_BAR; PG8_SCHED;
            PG8_LDA(At, 0, 1); PG8_STAGE(PG8_SB(0, 0), b2, voffB); PG8_STAGE(PG8_SB(0, 1), b2 + hstepB, voffB); PG8_STAGE(PG8_SA(0, 0), a2, voffA);
            PG8_WAIT_V(8); PG8_WAIT_L(0); PG8_BAR; PG8_MMA(1, 0, At, B0); PG8_MMA(1, 1, At, B1); PG8_BAR; PG8_SCHED;
            PG8_LDB(B0, 1, 0); PG8_LDB(B1, 1, 1); PG8_SCHED; PG8_LDA(At, 1, 0); PG8_STAGE(PG8_SA(0, 1), a2 + hstepA, voffA);
            PG8_WAIT_V(8); PG8_WAIT_L(0); PG8_BAR; PG8_MMA(0, 0, At, B0); PG8_MMA(0, 1, At, B1); PG8_BAR; PG8_SCHED;
            PG8_LDA(At, 1, 1); PG8_STAGE(PG8_SB(1, 0), b3, voffB); PG8_STAGE(PG8_SB(1, 1), b3 + hstepB, voffB); PG8_STAGE(PG8_SA(1, 0), a3, voffA);
            PG8_WAIT_V(8); PG8_WAIT_L(0); PG8_BAR; PG8_MMA(1, 0, At, B0); PG8_MMA(1, 1, At, B1); PG8_BAR; PG8_SCHED;
        }
        if (wr == 0) PG8_BAR;
        E(acc, cur, wr, wc, fr, fq);
        if (!has_next) break;
#pragma unroll
        for (int a = 0; a < 2; ++a)
#pragma unroll
            for (int b = 0; b < 2; ++b)
#pragma unroll
                for (int m = 0; m < 4; ++m)
#pragma unroll
                    for (int n = 0; n < 2; ++n) acc[a][b][m][n] = (f32x4){0.f, 0.f, 0.f, 0.f};
        cur = nxt; cA = nA; cB = nB; ++ui;
        if (wr == 1) PG8_BAR;
    }
    PG8_WAIT_V(0);
    PG8_BAR;
#undef PG8_SA
#undef PG8_SB
#undef PG8_STAGE
#undef PG8_LDA
#undef PG8_LDB
#undef PG8_MMA
#undef PG8_WAIT_V
#undef PG8_WAIT_L
#undef PG8_BAR
#undef PG8_SCHED
}

template <class Epi, class Sched>
__device__ __forceinline__ void slow_gemm_phase(LAS unsigned char* lds, const int K, const int lda, const int ldb, const Sched& S, const Epi& E) {
    const int tid = threadIdx.x, wid = __builtin_amdgcn_readfirstlane(tid >> 6), lane = tid & 63, wr = wid >> 2, wc = wid & 3, fr = lane & 15, fq = lane >> 4;
    Unit u;
    for (int ui = 0; S.next(ui, u); ++ui) {
        f32x4 acc[2][2][4][2];
#pragma unroll
        for (int a = 0; a < 2; ++a)
#pragma unroll
            for (int b = 0; b < 2; ++b)
#pragma unroll
                for (int m = 0; m < 4; ++m)
#pragma unroll
                    for (int n = 0; n < 2; ++n) acc[a][b][m][n] = (f32x4){0.f, 0.f, 0.f, 0.f};
        const char* pA = S.a_base(u); const char* pB = S.b_base(u);
        const unsigned ao = (unsigned)((64 * wr + fr) * lda * 2);
        const unsigned bo = (unsigned)((32 * wc + (Epi::PERM ? 8 * fq : 4 * fq)) * ldb * 2);
        for (int k0 = 0; k0 < K; k0 += 8, pA += 16, pB += 16) {
#pragma unroll
            for (int bj = 0; bj < 2; ++bj)
#pragma unroll
                for (int n = 0; n < 2; ++n)
#pragma unroll
                    for (int e = 0; e < 4; ++e) {
                        const int colr = Epi::PERM ? (128 * bj + 4 * n + e) : (128 * bj + 16 * n + e);
                        const u32x4 bw = *(const u32x4*)(pB + (bo + (unsigned)(colr * ldb * 2)));
#pragma unroll
                        for (int ai = 0; ai < 2; ++ai)
#pragma unroll
                            for (int m = 0; m < 4; ++m) {
                                const u32x4 aw = *(const u32x4*)(pA + (ao + (unsigned)((128 * ai + 16 * m) * lda * 2)));
                                float s = acc[ai][bj][m][n][e];
                                s += __uint_as_float(aw.x << 16) * __uint_as_float(bw.x << 16) + __uint_as_float(aw.x & 0xffff0000u) * __uint_as_float(bw.x & 0xffff0000u);
                                s += __uint_as_float(aw.y << 16) * __uint_as_float(bw.y << 16) + __uint_as_float(aw.y & 0xffff0000u) * __uint_as_float(bw.y & 0xffff0000u);
                                s += __uint_as_float(aw.z << 16) * __uint_as_float(bw.z << 16) + __uint_as_float(aw.z & 0xffff0000u) * __uint_as_float(bw.z & 0xffff0000u);
                                s += __uint_as_float(aw.w << 16) * __uint_as_float(bw.w << 16) + __uint_as_float(aw.w & 0xffff0000u) * __uint_as_float(bw.w & 0xffff0000u);
                                acc[ai][bj][m][n][e] = s;
                                asm volatile("" ::: "memory");
                            }
                    }
        }
        E(acc, u, wr, wc, fr, fq);
    }
    __syncthreads();
}
}

struct Args { const void* in[14]; float* out; unsigned char* ws; int ph_lo, ph_hi; };
struct Frame {
    LAS unsigned char* lds;
    int tid, lane, wave, vcu, G;
    const Args* a;
    __device__ __forceinline__ const float* inf(int i) const { return (const float*)a->in[i]; }
#define FIN(name, idx) __device__ __forceinline__ const float* name() const { return inf(idx); }
    FIN(x, 0) FIN(c, 1) FIN(w_ada, 3) FIN(b_ada, 4) FIN(gain, 5) FIN(w_in, 6) FIN(wpg, 7) FIN(pscale, 8) FIN(qg, 9) FIN(kg, 10) FIN(w_a, 11) FIN(w_b, 12) FIN(w_out, 13)
#undef FIN
    __device__ __forceinline__ const int* positions() const { return (const int*)a->in[2]; }
    __device__ __forceinline__ float* out() const { return a->out; }
#define FWS(type, name, off) __device__ __forceinline__ type* name() const { return (type*)(a->ws + (off)); }
    FWS(float, MOD, WS_MOD) FWS(float, WI, WS_WI) FWS(bf16_t, WIN, WS_WIN) FWS(bf16_t, WPG, WS_WPG) FWS(bf16_t, WA, WS_WA) FWS(bf16_t, WB, WS_WB) FWS(bf16_t, WOUT, WS_WOUT)
    FWS(bf16_t, H, WS_H) FWS(bf16_t, UA, WS_UA) FWS(bf16_t, POOL, WS_POOL) FWS(bf16_t, ZA, WS_ZA) FWS(bf16_t, Q, WS_Q) FWS(bf16_t, ZB, WS_ZB) FWS(bf16_t, GA, WS_GA) FWS(bf16_t, GB, WS_GB)
    FWS(bf16_t, YB, WS_YB) FWS(bf16_t, KB, WS_K) FWS(bf16_t, VB, WS_V) FWS(_Float16, QI, WS_QI) FWS(_Float16, KI, WS_KI)
#undef FWS
};

__device__ __forceinline__ void p0_mod(Frame& F) {
    const int blk = blockIdx.x; if (blk >= 192) return;
    const int kc = blk & 3, cc = blk >> 2, k0 = 256 * kc, col0 = 64 * cc;
    LAS float* sc = (LAS float*)F.lds;
    LAS float* red = (LAS float*)(F.lds + 32768);
    for (int idx = F.tid; idx < 8192; idx += NTHREADS) { const int b = idx >> 8, kk = idx & 255; const float cv = F.c()[b * DMODEL + k0 + kk]; sc[kk * 32 + b] = cv / (1.0f + expf(-cv)); }
    __syncthreads();
    float acc[32];
#pragma unroll
    for (int b = 0; b < 32; ++b) acc[b] = 0.f;
    for (int kk = 32 * F.wave; kk < 32 * F.wave + 32; ++kk) {
        const float wv = F.w_ada()[(size_t)(k0 + kk) * 3072 + col0 + F.lane];
#pragma unroll
        for (int b4 = 0; b4 < 8; ++b4) { const f32x4 s = *(const LAS f32x4*)(sc + kk * 32 + 4 * b4);
            acc[4 * b4 + 0] += s[0] * wv; acc[4 * b4 + 1] += s[1] * wv; acc[4 * b4 + 2] += s[2] * wv; acc[4 * b4 + 3] += s[3] * wv; }
    }
#pragma unroll
    for (int b = 0; b < 32; ++b) red[(F.wave * 32 + b) * 64 + F.lane] = acc[b];
    __syncthreads();
    for (int o = F.tid; o < 2048; o += NTHREADS) { const int b = o >> 6, col = o & 63; float s = 0.f;
#pragma unroll
        for (int w = 0; w < 8; ++w) s += red[(w * 32 + b) * 64 + col];
        if (kc == 0) s += F.b_ada()[col0 + col];
        unsafeAtomicAdd(F.MOD() + b * 3072 + col0 + col, s); }
    __syncthreads();
}

struct ColGrp { int base, nvalid, perm; };
__device__ __forceinline__ ColGrp win_group(int G) {
    const int pn = G >> 3, gi = G & 7, bj = gi >> 2, wc = gi & 3; ColGrp g; g.nvalid = 32; g.perm = 0; g.base = 0;
    if (pn < 2) g.base = 0 + 256 * pn + 32 * gi;
    else if (pn < 4) g.base = 512 + 256 * (pn - 2) + 32 * gi;
    else if (pn < 6) { g.base = 1024 + (4 * (pn - 4) + wc) * 64 + 32 * bj; g.perm = (bj == 0); }
    else if (pn == 6) {
        if (wc == 0) { g.base = 1536 + 32 * bj; g.perm = (bj == 0); }
        else if (wc == 1) g.base = 1600 + 32 * bj;
        else if (wc == 2) { g.base = 2688 + 32 * bj; g.perm = (bj == 0); }
        else { g.base = 2752; g.nvalid = bj == 0 ? 8 : 0; }
    }
    else if (pn < 9) g.base = 1664 + 256 * (pn - 7) + 32 * gi;
    else if (pn < 11) { g.base = 2176 + (4 * (pn - 9) + wc) * 64 + 32 * bj; g.perm = (bj == 0); }
    else if (pn < 15) g.base = 2760 + 256 * (pn - 11) + 32 * gi;
    else g.base = 3784 + 256 * (pn - 15) + 32 * gi;
    return g;
}
__device__ __forceinline__ int sigma16(int p) { return p < 16 ? 4 * (p >> 3) + 8 * ((p >> 2) & 1) + (p & 3) : p; }

__device__ __forceinline__ void transpose_item(const float* W, int ldw, int k0, ColGrp g, bf16_t* WT, int ldk, int dst_row0, int dst_k0, LAS float* scr, int lane) {
#pragma unroll 8
    for (int i = 0; i < 32; ++i) { const int kk = 2 * i + (lane >> 5), n = lane & 31; scr[kk * 33 + n] = (n < g.nvalid) ? W[(size_t)(k0 + kk) * ldw + g.base + n] : 0.f; }
    asm volatile("s_waitcnt lgkmcnt(0)" ::: "memory");
    const int c = lane & 7;
#pragma unroll
    for (int j = 0; j < 4; ++j) { const int n = (lane >> 3) + 8 * j; const int sn = g.perm ? sigma16(n) : n; const LAS float* s = scr + (8 * c) * 33 + sn;
        u32x4 o; o.x = cvt_pk_bf16(s[0 * 33], s[1 * 33]); o.y = cvt_pk_bf16(s[2 * 33], s[3 * 33]); o.z = cvt_pk_bf16(s[4 * 33], s[5 * 33]); o.w = cvt_pk_bf16(s[6 * 33], s[7 * 33]);
        *(u32x4*)(WT + (size_t)(dst_row0 + n) * ldk + dst_k0 + 8 * c) = o; }
    asm volatile("s_waitcnt lgkmcnt(0)" ::: "memory");
}
__device__ __forceinline__ void p0_weights(Frame& F) {
    LAS float* scr = (LAS float*)(F.lds + F.wave * 8704);
    const int gw = F.vcu * NWAVES + F.wave, NGW = F.G * NWAVES;
    constexpr int I_IN = 16 * 152, I_A = 8 * 32, I_B = 8 * 32, I_OUT = 16 * 32, I_PG = 2 * 4 * 8, NITEMS = I_IN + I_A + I_B + I_OUT + I_PG;
    for (int it = gw; it < NITEMS; it += NGW) {
        int r = it;
        if (r < I_IN) { const int kb = r / 152, G = r % 152; transpose_item(F.w_in(), 4808, 64 * kb, win_group(G), F.WIN(), 1024, 32 * G, 64 * kb, scr, F.lane); continue; } r -= I_IN;
        if (r < I_A) { const int kb = r / 32, G = r % 32; ColGrp g{32 * G, 32, 0}; transpose_item(F.w_a(), 1024, 64 * kb, g, F.WA(), 512, 32 * G, 64 * kb, scr, F.lane); continue; } r -= I_A;
        if (r < I_B) { const int kb = r / 32, G = r % 32; ColGrp g{32 * G, 32, 0}; transpose_item(F.w_b(), 1024, 64 * kb, g, F.WB(), 512, 32 * G, 64 * kb, scr, F.lane); continue; } r -= I_B;
        if (r < I_OUT) { const int kb = r / 32, G = r % 32; ColGrp g{32 * G, 32, 0}; transpose_item(F.w_out(), 1024, 64 * kb, g, F.WOUT(), 1024, 32 * G, 64 * kb, scr, F.lane); continue; } r -= I_OUT;
        { const int p = r >> 5, kb = (r >> 3) & 3, G8 = r & 7; const int n0 = 32 * G8, gl = n0 >> 7, kd = 64 * kb, gk = kd >> 7;
          ColGrp g{n0 & 127, gl == gk ? 32 : 0, 0};
          transpose_item(F.wpg() + (size_t)(2 * p + gl) * 16384, 128, kd & 127, g, F.WPG() + (size_t)p * 65536, 256, n0, kd, scr, F.lane); }
    }
}

__device__ __forceinline__ void p1_rows(Frame& F) {
    const int gw = F.vcu * NWAVES + F.wave, NGW = F.G * NWAVES;
    for (int task = gw; task < MROWS / 32; task += NGW) {
        const int r0 = task * 32, b = r0 / SEQ;
        const float* md = F.MOD() + b * 3072;
        f32x4 gp[4], sh[4];
#pragma unroll
        for (int j = 0; j < 4; ++j) { const int k = 4 * F.lane + 256 * j; const f32x4 g = *(const f32x4*)(F.gain() + k), s = *(const f32x4*)(md + 1024 + k); gp[j] = g * (1.0f + s); sh[j] = *(const f32x4*)(md + k); }
        for (int i = 0; i < 32; i += 2) {
            const f32x4* xa = (const f32x4*)(F.x() + (size_t)(r0 + i) * DMODEL) + F.lane; const f32x4* xb = xa + DMODEL / 4;
            f32x4 va[4], vb[4]; float sa = 0.f, sb = 0.f;
#pragma unroll
            for (int j = 0; j < 4; ++j) { va[j] = xa[64 * j]; vb[j] = xb[64 * j]; }
#pragma unroll
            for (int j = 0; j < 4; ++j) { sa += (va[j].x * va[j].x + va[j].y * va[j].y) + (va[j].z * va[j].z + va[j].w * va[j].w); sb += (vb[j].x * vb[j].x + vb[j].y * vb[j].y) + (vb[j].z * vb[j].z + vb[j].w * vb[j].w); }
            const float ra = rsqrtf(wave_sum(sa) * (1.0f / DMODEL) + EPS), rb = rsqrtf(wave_sum(sb) * (1.0f / DMODEL) + EPS);
            u32x2* oa = (u32x2*)(F.H() + (size_t)(r0 + i) * DMODEL) + F.lane; u32x2* ob = oa + DMODEL / 4;
#pragma unroll
            for (int j = 0; j < 4; ++j) { const f32x4 ha = va[j] * ra * gp[j] + sh[j], hb = vb[j] * rb * gp[j] + sh[j];
                u32x2 wa, wb; wa.x = cvt_pk_bf16(ha.x, ha.y); wa.y = cvt_pk_bf16(ha.z, ha.w); wb.x = cvt_pk_bf16(hb.x, hb.y); wb.y = cvt_pk_bf16(hb.z, hb.w);
                oa[64 * j] = wa; ob[64 * j] = wb; }
        }
    }
}

struct SchedTiles {
    const char* A; const char* B; size_t a_tile, a_pn, b_tile; int nM, nN, G, c;
    __device__ __forceinline__ bool next(int i, pg8::Unit& u) const { const long L = (long)i * G + c; if (L >= (long)nM * nN) return false; pg8::tile_of((int)L, nM, nN, u.pm, u.pn); u.z = 0; return true; }
    __device__ __forceinline__ const char* a_base(const pg8::Unit& u) const { return A + (size_t)u.pm * a_tile + (size_t)u.pn * a_pn; }
    __device__ __forceinline__ const char* b_base(const pg8::Unit& u) const { return B + (size_t)u.pn * b_tile; }
};
struct SchedMerge {
    const char* A0; const char* A1; const char* B0; const char* B1; int G, c, zf;
    __device__ __forceinline__ bool next(int i, pg8::Unit& u) const { const long L = (long)i * G + c; if (L >= 256 * 4) return false; pg8::tile_of((int)L, 256, 4, u.pm, u.pn); u.z = zf; return true; }
    __device__ __forceinline__ const char* a_base(const pg8::Unit& u) const { return (u.z ? A1 : A0) + (size_t)u.pm * (256 * 512 * 2); }
    __device__ __forceinline__ const char* b_base(const pg8::Unit& u) const { return (u.z ? B1 : B0) + (size_t)u.pn * (256 * 512 * 2); }
};

typedef f32x4 AccT[2][2][4][2];
__device__ __forceinline__ u32x4 pack8(const f32x4 a, const f32x4 b) { u32x4 w; w.x = cvt_pk_bf16(a[0], a[1]); w.y = cvt_pk_bf16(a[2], a[3]); w.z = cvt_pk_bf16(b[0], b[1]); w.w = cvt_pk_bf16(b[2], b[3]); return w; }
__device__ __forceinline__ f32x4 silu4(f32x4 v) { return (f32x4){fast_silu(v[0]), fast_silu(v[1]), fast_silu(v[2]), fast_silu(v[3])}; }
__device__ __forceinline__ f32x4 sigm4(f32x4 v) { return (f32x4){fast_sigmoid(v[0]), fast_sigmoid(v[1]), fast_sigmoid(v[2]), fast_sigmoid(v[3])}; }

__device__ __forceinline__ void rope_tab(int pos, const float (&ifr)[4], float (&cs)[4], float (&sn)[4]) {
#pragma unroll
    for (int i = 0; i < 4; ++i) { const float ang = (float)pos * ifr[i]; const float k = rintf(ang * 0.15915494309189535f);
        float r = fmaf(-k, 6.2831854820251465f, ang); r = fmaf(-k, -1.7484556000744487e-07f, r);
        const float rv = r * 0.15915494309189535f; cs[i] = __builtin_amdgcn_cosf(rv); sn[i] = __builtin_amdgcn_sinf(rv); }
}

struct EpiProj {
    static constexpr bool PERM = true;
    const Args* a;
    template <int ACT> __device__ __forceinline__ void plain(const AccT& acc, bf16_t* O, int ld, int colt, int pm, int wr, int wc, int fr, int fq) const {
        const int row0 = pm * 256 + wr * 64 + fr, col0 = colt + wc * 32 + 8 * fq;
#pragma unroll
        for (int ai = 0; ai < 2; ++ai)
#pragma unroll
            for (int m = 0; m < 4; ++m) { bf16_t* rowp = O + (size_t)(row0 + ai * 128 + m * 16) * ld + col0;
#pragma unroll
                for (int bj = 0; bj < 2; ++bj) { f32x4 v0 = acc[ai][bj][m][0], v1 = acc[ai][bj][m][1];
                    if (ACT == 1) { v0 = silu4(v0); v1 = silu4(v1); } if (ACT == 2) { v0 = sigm4(v0); v1 = sigm4(v1); }
                    *(u32x4*)(rowp + bj * 128) = pack8(v0, v1); }
                asm volatile("" ::: "memory"); }
    }
    template <bool NORM, bool F16> __device__ __forceinline__ void head(const AccT& acc, void* O, int ld, int colh, const float* gain, float oscale, int pm, int wr, int fr, int fq) const {
        const int row0 = pm * 256 + wr * 64 + fr;
        float gp[2][2][4];
#pragma unroll
        for (int bj = 0; bj < 2; ++bj)
#pragma unroll
            for (int n = 0; n < 2; ++n)
#pragma unroll
                for (int i = 0; i < 4; ++i) { const int dim = bj == 0 ? (fq < 2 ? 4 * fq + 8 * n + i : 8 * fq + 4 * n + i) : 32 + 8 * fq + 4 * n + i; gp[bj][n][i] = NORM ? gain[dim] * oscale : oscale; }
        float ifr[4];
#pragma unroll
        for (int i = 0; i < 4; ++i) ifr[i] = exp2f(-(float)(4 * (fq & 1) + i) * (18.931568569324174f / 8.0f));
#pragma unroll
        for (int ai = 0; ai < 2; ++ai)
#pragma unroll
            for (int m = 0; m < 4; ++m) { const int row = row0 + ai * 128 + m * 16;
                f32x4 v[2][2];
#pragma unroll
                for (int bj = 0; bj < 2; ++bj)
#pragma unroll
                    for (int n = 0; n < 2; ++n) v[bj][n] = acc[ai][bj][m][n];
                float rinv = 1.0f;
                if (NORM) { float ss = 0.f;
#pragma unroll
                    for (int bj = 0; bj < 2; ++bj)
#pragma unroll
                        for (int n = 0; n < 2; ++n) ss += (v[bj][n][0] * v[bj][n][0] + v[bj][n][1] * v[bj][n][1]) + (v[bj][n][2] * v[bj][n][2] + v[bj][n][3] * v[bj][n][3]);
                    ss += __shfl_xor(ss, 16); ss += __shfl_xor(ss, 32); rinv = rsqrtf(ss * (1.0f / 64.0f) + EPS); }
#pragma unroll
                for (int bj = 0; bj < 2; ++bj)
#pragma unroll
                    for (int n = 0; n < 2; ++n)
#pragma unroll
                        for (int i = 0; i < 4; ++i) v[bj][n][i] = v[bj][n][i] * rinv * gp[bj][n][i];
                float cs[4], sn[4]; rope_tab(((const int*)a->in[2])[row], ifr, cs, sn);
                if (fq < 2) {
#pragma unroll
                    for (int i = 0; i < 4; ++i) { const float x1 = v[0][0][i], x2 = v[0][1][i]; v[0][0][i] = x1 * cs[i] - x2 * sn[i]; v[0][1][i] = x2 * cs[i] + x1 * sn[i]; } }
#pragma unroll
                for (int bj = 0; bj < 2; ++bj) { u32x4 w;
                    if (F16) { w.x = pk_f16(v[bj][0][0], v[bj][0][1]); w.y = pk_f16(v[bj][0][2], v[bj][0][3]); w.z = pk_f16(v[bj][1][0], v[bj][1][1]); w.w = pk_f16(v[bj][1][2], v[bj][1][3]); }
                    else w = pack8(v[bj][0], v[bj][1]);
                    *(u32x4*)((unsigned short*)O + (size_t)row * ld + colh + 32 * bj + 8 * fq) = w; }
                asm volatile("" ::: "memory"); }
    }
    __device__ __forceinline__ void operator()(const AccT& acc, const pg8::Unit& u, int wr, int wc, int fr, int fq) const {
        asm volatile("" : "+v"(fr), "+v"(fq));
        const int pn = u.pn, pm = u.pm; unsigned char* ws = a->ws;
        if (pn < 2) plain<0>(acc, (bf16_t*)(ws + WS_UA), 512, 256 * pn, pm, wr, wc, fr, fq);
        else if (pn < 4) plain<1>(acc, (bf16_t*)(ws + WS_ZA), 512, 256 * (pn - 2), pm, wr, wc, fr, fq);
        else if (pn < 6) head<true, false>(acc, ws + WS_Q, 512, (4 * (pn - 4) + wc) * 64, (const float*)a->in[9], C2, pm, wr, fr, fq);
        else if (pn == 6) {
            if (wc == 0) head<true, false>(acc, ws + WS_K, 64, 0, (const float*)a->in[10], 1.0f, pm, wr, fr, fq);
            else if (wc == 1) {
                const int row0 = pm * 256 + wr * 64 + fr; bf16_t* VB = (bf16_t*)(ws + WS_V);
#pragma unroll
                for (int ai = 0; ai < 2; ++ai)
#pragma unroll
                    for (int m = 0; m < 4; ++m)
#pragma unroll
                        for (int bj = 0; bj < 2; ++bj) *(u32x4*)(VB + (size_t)(row0 + ai * 128 + m * 16) * 64 + 32 * bj + 8 * fq) = pack8(acc[ai][bj][m][0], acc[ai][bj][m][1]);
            }
            else if (wc == 2) head<false, true>(acc, ws + WS_KI, 64, 0, nullptr, 1.0f, pm, wr, fr, fq);
            else { if (fq == 0) { const int row0 = pm * 256 + wr * 64 + fr; const float wsc = 0.35355339059327373f * 0.125f; float* WI = (float*)(ws + WS_WI);
#pragma unroll
                for (int ai = 0; ai < 2; ++ai)
#pragma unroll
                    for (int m = 0; m < 4; ++m) { float* wp = WI + (size_t)(row0 + ai * 128 + m * 16) * 8; *(f32x4*)wp = acc[ai][0][m][0] * wsc; *(f32x4*)(wp + 4) = acc[ai][0][m][1] * wsc; } } }
        }
        else if (pn < 9) plain<1>(acc, (bf16_t*)(ws + WS_ZB), 512, 256 * (pn - 7), pm, wr, wc, fr, fq);
        else if (pn < 11) head<false, true>(acc, ws + WS_QI, 512, (4 * (pn - 9) + wc) * 64, nullptr, 1.0f, pm, wr, fr, fq);
        else if (pn < 15) plain<2>(acc, (bf16_t*)(ws + WS_GA), 1024, 256 * (pn - 11), pm, wr, wc, fr, fq);
        else plain<2>(acc, (bf16_t*)(ws + WS_GB), 1024, 256 * (pn - 15), pm, wr, wc, fr, fq);
    }
};

struct EpiMix {
    static constexpr bool PERM = true;
    bf16_t* YA; const bf16_t* ZA; const float* pscale;
    __device__ __forceinline__ void operator()(const AccT& acc, const pg8::Unit& u, int wr, int wc, int fr, int fq) const {
        asm volatile("" : "+v"(fr), "+v"(fq));
        const int row0 = u.pm * 256 + wr * 64 + fr, col0 = u.pn * 256 + wc * 32 + 8 * fq;
        f32x4 ps[2][2];
#pragma unroll
        for (int bj = 0; bj < 2; ++bj) { ps[bj][0] = *(const f32x4*)(pscale + col0 + bj * 128); ps[bj][1] = *(const f32x4*)(pscale + col0 + bj * 128 + 4); }
#pragma unroll
        for (int ai = 0; ai < 2; ++ai)
#pragma unroll
            for (int m = 0; m < 4; ++m) { const size_t off = (size_t)(row0 + ai * 128 + m * 16) * 512 + col0;
#pragma unroll
                for (int bj = 0; bj < 2; ++bj) { const u32x4 z = *(const u32x4*)(ZA + off + bj * 128);
                    f32x4 v0 = acc[ai][bj][m][0] * ps[bj][0], v1 = acc[ai][bj][m][1] * ps[bj][1];
                    v0 = v0 * (f32x4){bf_lo(z.x), bf_hi(z.x), bf_lo(z.y), bf_hi(z.y)}; v1 = v1 * (f32x4){bf_lo(z.z), bf_hi(z.z), bf_lo(z.w), bf_hi(z.w)};
                    *(u32x4*)(YA + off + bj * 128) = pack8(v0, v1); }
                asm volatile("" ::: "memory"); }
    }
};
struct EpiMerge {
    static constexpr bool PERM = true;
    bf16_t* MG; const bf16_t* GA; const bf16_t* GB;
    __device__ __forceinline__ void operator()(const AccT& acc, const pg8::Unit& u, int wr, int wc, int fr, int fq) const {
        asm volatile("" : "+v"(fr), "+v"(fq));
        const int row0 = u.pm * 256 + wr * 64 + fr, col0 = u.pn * 256 + wc * 32 + 8 * fq; const bf16_t* Gt = u.z ? GB : GA;
#pragma unroll
        for (int ai = 0; ai < 2; ++ai)
#pragma unroll
            for (int m = 0; m < 4; ++m) { const size_t off = (size_t)(row0 + ai * 128 + m * 16) * 1024 + col0;
#pragma unroll
                for (int bj = 0; bj < 2; ++bj) { const u32x4 g = *(const u32x4*)(Gt + off + bj * 128);
                    f32x4 v0 = acc[ai][bj][m][0] * (f32x4){bf_lo(g.x), bf_hi(g.x), bf_lo(g.y), bf_hi(g.y)}, v1 = acc[ai][bj][m][1] * (f32x4){bf_lo(g.z), bf_hi(g.z), bf_lo(g.w), bf_hi(g.w)};
                    if (u.z) { const u32x4 p = *(const u32x4*)(MG + off + bj * 128); v0 = v0 + (f32x4){bf_lo(p.x), bf_hi(p.x), bf_lo(p.y), bf_hi(p.y)}; v1 = v1 + (f32x4){bf_lo(p.z), bf_hi(p.z), bf_lo(p.w), bf_hi(p.w)}; }
                    *(u32x4*)(MG + off + bj * 128) = pack8(v0, v1); }
                asm volatile("" ::: "memory"); }
    }
};
struct EpiOut {
    static constexpr bool PERM = false;
    const float* x; float* out; const float* MOD;
    __device__ __forceinline__ void operator()(const AccT& acc, const pg8::Unit& u, int wr, int wc, int fr, int fq) const {
        asm volatile("" : "+v"(fr), "+v"(fq));
        const int row0 = u.pm * 256 + wr * 64 + fr, col0 = u.pn * 256 + wc * 32 + 4 * fq; const int b = (u.pm * 256) / SEQ;
        f32x4 gt[2][2];
#pragma unroll
        for (int bj = 0; bj < 2; ++bj)
#pragma unroll
            for (int n = 0; n < 2; ++n) gt[bj][n] = *(const f32x4*)(MOD + b * 3072 + 2048 + col0 + bj * 128 + n * 16);
#pragma unroll
        for (int ai = 0; ai < 2; ++ai)
#pragma unroll
            for (int m = 0; m < 4; ++m) { const size_t off = (size_t)(row0 + ai * 128 + m * 16) * 1024 + col0;
#pragma unroll
                for (int bj = 0; bj < 2; ++bj)
#pragma unroll
                    for (int n = 0; n < 2; ++n) { const f32x4 xv = *(const f32x4*)(x + off + bj * 128 + n * 16); *(f32x4*)(out + off + bj * 128 + n * 16) = xv + gt[bj][n] * acc[ai][bj][m][n]; }
                asm volatile("" ::: "memory"); }
    }
};

__device__ __forceinline__ void ld8(const bf16_t* p, float (&v)[8]) { const u32x4 w = *(const u32x4*)p; v[0] = bf_lo(w.x); v[1] = bf_hi(w.x); v[2] = bf_lo(w.y); v[3] = bf_hi(w.y); v[4] = bf_lo(w.z); v[5] = bf_hi(w.z); v[6] = bf_lo(w.w); v[7] = bf_hi(w.w); }
__device__ __forceinline__ void p3_pool(Frame& F) {
    const int gw = F.vcu * NWAVES + F.wave, NGW = F.G * NWAVES;
    const int g = F.lane >> 4, w = 2 << g;
    for (int task = gw; task < MROWS / 32; task += NGW) {
        const int r0 = task * 32, t0 = r0 & (SEQ - 1);
        const bf16_t* up = F.UA() + (size_t)r0 * 512 + 8 * F.lane; bf16_t* pp = F.POOL() + (size_t)r0 * 512 + 8 * F.lane;
        float sum[8];
#pragma unroll
        for (int e = 0; e < 8; ++e) sum[e] = 0.f;
        if (t0 > 0) { for (int j = 1; j < 16; ++j) if (j < w) { float v[8]; ld8(up - (ptrdiff_t)j * 512, v);
#pragma unroll
            for (int e = 0; e < 8; ++e) sum[e] += v[e]; } }
        for (int i = 0; i < 32; ++i) {
            const int t = t0 + i; float cur[8]; ld8(up + (size_t)i * 512, cur);
            const int cnt = (t + 1) < w ? (t + 1) : w; const float rc = 1.0f / (float)cnt;
            float o[8];
#pragma unroll
            for (int e = 0; e < 8; ++e) { sum[e] += cur[e]; o[e] = sum[e] * rc - cur[e]; }
            u32x4 ow; ow.x = cvt_pk_bf16(o[0], o[1]); ow.y = cvt_pk_bf16(o[2], o[3]); ow.z = cvt_pk_bf16(o[4], o[5]); ow.w = cvt_pk_bf16(o[6], o[7]);
            *(u32x4*)(pp + (size_t)i * 512) = ow;
            if (t - w + 1 >= 0) { float old[8]; ld8(up + (ptrdiff_t)(i - w + 1) * 512, old);
#pragma unroll
                for (int e = 0; e < 8; ++e) sum[e] -= old[e]; }
        }
    }
}

constexpr int AT_BUF = 0, AT_MASK = 65536, AT_MASK_LD = 66, AT_WSF = AT_MASK + 32 * AT_MASK_LD * 4, AT_OST = AT_WSF + NWAVES * 256, AT_END = AT_OST + NWAVES * 4096;
static_assert(AT_END <= RING_BYTES, "attention LDS map");
__device__ __forceinline__ int crow(int r, int hi) { return (r & 3) + 8 * (r >> 2) + 4 * hi; }
__device__ __forceinline__ void glds16(const void* gsrc, LAS unsigned char* dst_uniform) { __builtin_amdgcn_global_load_lds((const unsigned*)gsrc, (LAS unsigned*)dst_uniform, 16, 0, 0); }
__device__ __forceinline__ unsigned half_sum_u32(unsigned v) {
    v += (unsigned)__builtin_amdgcn_update_dpp(0, (int)v, 0xB1, 0xF, 0xF, true);
    v += (unsigned)__builtin_amdgcn_update_dpp(0, (int)v, 0x4E, 0xF, 0xF, true);
    v += (unsigned)__builtin_amdgcn_update_dpp(0, (int)v, 0x141, 0xF, 0xF, true);
    v += (unsigned)__builtin_amdgcn_update_dpp(0, (int)v, 0x140, 0xF, 0xF, true);
    v += (unsigned)__builtin_amdgcn_ds_swizzle((int)v, 0x401F);
    return v;
}
__device__ __forceinline__ unsigned fkey(float f) { const unsigned u = __float_as_uint(f); return u ^ ((u >> 31) ? 0xFFFFFFFFu : 0x80000000u); }
__device__ __forceinline__ float fkey_inv(unsigned k) { return __uint_as_float(k ^ ((k >> 31) ? 0x80000000u : 0xFFFFFFFFu)); }
__device__ __forceinline__ float half_max(float v) {
#pragma unroll
    for (int o = 1; o < 32; o <<= 1) v = fmaxf(v, __shfl_xor(v, o));
    return v;
}
__device__ __forceinline__ float half_min(float v) {
#pragma unroll
    for (int o = 1; o < 32; o <<= 1) v = fminf(v, __shfl_xor(v, o));
    return v;
}

#ifndef SEL_VAL_ITERS
#define SEL_VAL_ITERS 8
#endif
#ifndef DSA_REP_P1
#define DSA_REP_P1 1
#endif
#ifndef DSA_REP_SEL
#define DSA_REP_SEL 1
#endif
#ifndef DSA_REP_P2
#define DSA_REP_P2 1
#endif
#define CNT_GE(cnt, v, thr) asm volatile("v_cmp_ge_f32_e32 vcc, %1, %2\n\tv_addc_co_u32_e32 %0, vcc, 0, %0, vcc" : "+v"(cnt) : "v"(v), "v"(thr) : "vcc")
__device__ __forceinline__ void dsa_unit(Frame& F, int b, int qb, float cshift) {
    LAS unsigned char* lds = F.lds;
    int lane_ = F.lane; asm volatile("" : "+v"(lane_));
    const int lane = lane_, w = F.wave, c32 = lane & 31, hh = lane >> 5;
    const int q0 = 32 * qb, S = q0 + 32; const size_t row0 = (size_t)b * SEQ;
    const int nch = (S + 255) >> 8;
    LAS unsigned* MASK = (LAS unsigned*)(lds + AT_MASK);
    f16x8 af[4];
    { const int r = c32, ahh = (r >> 2) & 1, y = (r >> 4) & 1, head = (r & 3) + 4 * ((r >> 3) & 1), qsel = 2 * ahh + y;
      const _Float16* qip = F.QI() + (row0 + q0 + 4 * w + qsel) * 512 + head * 64 + 8 * hh;
#pragma unroll
      for (int ks = 0; ks < 4; ++ks) af[ks] = *(const f16x8*)(qip + 16 * ks); }
    const int qX = q0 + 4 * w + 2 * hh, qY = qX + 1;
    f32x4 wx0, wx1, wy0, wy1;
    { const float* wip = F.WI() + (row0 + qX) * 8; wx0 = *(const f32x4*)wip; wx1 = *(const f32x4*)(wip + 4); wy0 = *(const f32x4*)(wip + 8); wy1 = *(const f32x4*)(wip + 12); }
    const _Float16* kisrc = F.KI() + (row0 + lane) * 64 + w * 8;
#define KI_DMA(ch) do { const _Float16* p_ = kisrc; asm volatile("" : "+v"(p_));   \
        _Pragma("unroll") for (int g_ = 0; g_ < 4; ++g_) glds16(p_ + (size_t)((ch) * 256 + g_ * 64) * 64, lds + AT_BUF + ((ch) & 1) * 32768 + w * 4096 + g_ * 1024); } while (0)
    float sx[64], sy[64];
    for (int rp1_ = 0; rp1_ < DSA_REP_P1; ++rp1_) { if (rp1_) __syncthreads();
    KI_DMA(0);
#pragma unroll
    for (int ch = 0; ch < 8; ++ch) {
        if (ch < nch) {
            asm volatile("s_waitcnt vmcnt(0)" ::: "memory"); __syncthreads();
            if (ch + 1 < nch) KI_DMA(ch + 1);
            const LAS unsigned char* kb = lds + AT_BUF + (ch & 1) * 32768 + hh * 4096 + c32 * 16;
#pragma unroll
            for (int t = 0; t < 8; ++t) {
                const int T = 8 * ch + t;
                if (32 * T < S) {
                    f32x16 acc = {};
#pragma unroll
                    for (int ks = 0; ks < 4; ++ks) { const f16x8 bfr = *(const LAS f16x8*)(kb + ks * 8192 + t * 512); acc = __builtin_amdgcn_mfma_f32_32x32x16_f16(af[ks], bfr, acc, 0, 0, 0); }
                    float ax = 0.f, ay = 0.f;
#pragma unroll
                    for (int j = 0; j < 4; ++j) { ax += fmaxf(acc[j], 0.f) * wx0[j]; ay += fmaxf(acc[8 + j], 0.f) * wy0[j]; }
#pragma unroll
                    for (int j = 0; j < 4; ++j) { ax += fmaxf(acc[4 + j], 0.f) * wx1[j]; ay += fmaxf(acc[12 + j], 0.f) * wy1[j]; }
                    if (T == qb) { ax = c32 <= (qX & 31) ? ax : -INFINITY; ay = c32 <= (qY & 31) ? ay : -INFINITY; }
                    sx[T] = ax; sy[T] = ay;
                } else { sx[T] = -INFINITY; sy[T] = -INFINITY; }
                __builtin_amdgcn_sched_barrier(0);
            }
        } else {
#pragma unroll
            for (int t = 0; t < 8; ++t) { sx[8 * ch + t] = -INFINITY; sy[8 * ch + t] = -INFINITY; }
        }
    }
    }
#undef KI_DMA
    float Tx = -3.0e38f, Ty = -3.0e38f; int needx = 0x7fffffff, needy = 0x7fffffff;
#ifndef NO_SEL
    for (int rps_ = 0; rps_ < DSA_REP_SEL; ++rps_) {
    {
        bool donex = (qX + 1) <= 256, doney = (qY + 1) <= 256;
        float lox, hix, loy, hiy; int chx = 0, chy = 0;
        { float mx = -INFINITY, mn = INFINITY, my = -INFINITY, ny = INFINITY;
#pragma unroll
          for (int T = 0; T < 64; ++T) { mx = fmaxf(mx, sx[T]); my = fmaxf(my, sy[T]); mn = fminf(mn, sx[T] == -INFINITY ? INFINITY : sx[T]); ny = fminf(ny, sy[T] == -INFINITY ? INFINITY : sy[T]); }
          mx = half_max(mx); my = half_max(my); lox = half_min(mn); loy = half_min(ny);
          hix = fkey_inv(fkey(mx) + 1u); hiy = fkey_inv(fkey(my) + 1u); }
        int it = 0;
        while (__any(!(donex && doney))) {
            float px, py;
            { const unsigned kl = fkey(lox), kh = fkey(hix); const unsigned km = kl + ((kh - kl) >> 1); px = fkey_inv(km);
              if (it < SEL_VAL_ITERS) { const float pv = 0.5f * lox + 0.5f * hix; if (pv > lox && pv < hix) px = pv; }
              if (!donex && !(px > lox && px < hix)) { donex = true; Tx = lox; needx = 256 - chx; } }
            { const unsigned kl = fkey(loy), kh = fkey(hiy); const unsigned km = kl + ((kh - kl) >> 1); py = fkey_inv(km);
              if (it < SEL_VAL_ITERS) { const float pv = 0.5f * loy + 0.5f * hiy; if (pv > loy && pv < hiy) py = pv; }
              if (!doney && !(py > loy && py < hiy)) { doney = true; Ty = loy; needy = 256 - chy; } }
            ++it;
            unsigned cx = 0, cy = 0;
#pragma unroll
            for (int ch = 0; ch < 8; ++ch) if (ch < nch) {
#pragma unroll
                for (int t = 0; t < 8; ++t) { CNT_GE(cx, sx[8 * ch + t], px); CNT_GE(cy, sy[8 * ch + t], py); } }
            const unsigned pk = half_sum_u32(cx | (cy << 16)); cx = pk & 0xffffu; cy = pk >> 16;
            if (!donex) { if (cx == 256u) { donex = true; Tx = px; needx = 0x7fffffff; } else if (cx > 256u) lox = px; else { hix = px; chx = (int)cx; } }
            if (!doney) { if (cy == 256u) { doney = true; Ty = py; needy = 0x7fffffff; } else if (cy > 256u) loy = py; else { hiy = py; chy = (int)cy; } }
        }
    }
    }
#endif
#ifndef NO_MASKW
    {
        int runx = 0, runy = 0; const unsigned below = (1u << c32) - 1u;
#pragma unroll
        for (int T = 0; T < 64; ++T) if (T < 2 * ((qb >> 1) + 1)) {
            const bool gx = sx[T] > Tx, ex = sx[T] == Tx, gy = sy[T] > Ty, ey = sy[T] == Ty;
            const unsigned long long bex = __ballot(ex), bey = __ballot(ey);
            const unsigned mex = hh ? (unsigned)(bex >> 32) : (unsigned)bex, mey = hh ? (unsigned)(bey >> 32) : (unsigned)bey;
            const bool selx = gx || (ex && (runx + (int)__popc(mex & below)) < needx), sely = gy || (ey && (runy + (int)__popc(mey & below)) < needy);
            runx += (int)__popc(mex); runy += (int)__popc(mey);
            const unsigned long long bsx = __ballot(selx), bsy = __ballot(sely);
            if (lane < 4) { const unsigned wd = lane == 0 ? (unsigned)bsx : lane == 1 ? (unsigned)bsy : lane == 2 ? (unsigned)(bsx >> 32) : (unsigned)(bsy >> 32);
                MASK[(4 * w + lane) * AT_MASK_LD + T] = wd; }
        }
    }
#endif
    __syncthreads();
#ifndef NO_P2
    const int NT = (qb >> 1) + 1;
    bf16x8 qr[4];
    { const bf16_t* Qw = F.Q() + (row0 + q0 + c32) * 512 + w * 64 + hh * 8;
#pragma unroll
      for (int d0 = 0; d0 < 4; ++d0) qr[d0] = *(const bf16x8*)(Qw + d0 * 16); }
    const bf16_t* ksrc = F.KB() + (row0 + lane) * 64 + w * 8;
    const bf16_t* vsrc = F.VB() + (row0 + 16 * (w & 3) + (lane >> 2)) * 64 + (w >> 2) * 32 + (lane & 3) * 8;
#define KV_DMA(t) do { glds16(ksrc + (size_t)(t) * 4096, lds + AT_BUF + ((t) & 1) * 16384 + w * 1024); glds16(vsrc + (size_t)(t) * 4096, lds + AT_BUF + ((t) & 1) * 16384 + 8192 + w * 1024); } while (0)
    f32x16 o0 = {}, o1 = {}; float l_reg = 0.f;
    for (int rp2_ = 0; rp2_ < DSA_REP_P2; ++rp2_) { if (rp2_) { __syncthreads(); o0 = f32x16{}; o1 = f32x16{}; l_reg = 0.f; }
    const float negc = -cshift;
    KV_DMA(0);
    for (int t = 0; t < NT; ++t) {
        asm volatile("s_waitcnt vmcnt(0)" ::: "memory"); __syncthreads();
        if (t + 1 < NT) KV_DMA(t + 1);
        const LAS unsigned char* Ks = lds + AT_BUF + (t & 1) * 16384; const LAS unsigned char* Vs = Ks + 8192;
        const u32x2 mw = *(const LAS u32x2*)(MASK + c32 * AT_MASK_LD + 2 * t);
        const unsigned w0 = mw.x >> (4 * hh), w1 = mw.y >> (4 * hh);
        f32x16 p0, p1;
#pragma unroll
        for (int r = 0; r < 16; ++r) { const int bp = (r & 3) + 8 * (r >> 2); p0[r] = ((w0 >> bp) & 1u) ? negc : -INFINITY; p1[r] = ((w1 >> bp) & 1u) ? negc : -INFINITY; }
        { const LAS unsigned char* kb = Ks + hh * 1024 + c32 * 16;
#pragma unroll
          for (int d0 = 0; d0 < 4; ++d0) { const bf16x8 b0 = *(const LAS bf16x8*)(kb + d0 * 2048), b1 = *(const LAS bf16x8*)(kb + d0 * 2048 + 512);
              p0 = __builtin_amdgcn_mfma_f32_32x32x16_bf16(b0, qr[d0], p0, 0, 0, 0); p1 = __builtin_amdgcn_mfma_f32_32x32x16_bf16(b1, qr[d0], p1, 0, 0, 0); } }
        float sacc = 0.f;
#pragma unroll
        for (int r = 0; r < 16; ++r) { p0[r] = __builtin_amdgcn_exp2f(p0[r]); p1[r] = __builtin_amdgcn_exp2f(p1[r]); sacc += p0[r] + p1[r]; }
        l_reg += sacc;
        bf16x8 pa[4];
        { u32x4 pw0, pw1, pw2, pw3;
          pw0 = (u32x4){cvt_pk_bf16(p0[0], p0[1]), cvt_pk_bf16(p0[2], p0[3]), cvt_pk_bf16(p0[4], p0[5]), cvt_pk_bf16(p0[6], p0[7])};
          pw1 = (u32x4){cvt_pk_bf16(p0[8], p0[9]), cvt_pk_bf16(p0[10], p0[11]), cvt_pk_bf16(p0[12], p0[13]), cvt_pk_bf16(p0[14], p0[15])};
          pw2 = (u32x4){cvt_pk_bf16(p1[0], p1[1]), cvt_pk_bf16(p1[2], p1[3]), cvt_pk_bf16(p1[4], p1[5]), cvt_pk_bf16(p1[6], p1[7])};
          pw3 = (u32x4){cvt_pk_bf16(p1[8], p1[9]), cvt_pk_bf16(p1[10], p1[11]), cvt_pk_bf16(p1[12], p1[13]), cvt_pk_bf16(p1[14], p1[15])};
          pa[0] = __builtin_bit_cast(bf16x8, pw0); pa[1] = __builtin_bit_cast(bf16x8, pw1); pa[2] = __builtin_bit_cast(bf16x8, pw2); pa[3] = __builtin_bit_cast(bf16x8, pw3); }
        { const LAS unsigned char* vb = Vs + ((lane >> 4) & 1) * 32 + (lane & 3) * 8 + (4 * hh + ((lane & 15) >> 2)) * 64;
#pragma unroll
          for (int d0 = 0; d0 < 2; ++d0) {
#pragma unroll
              for (int ks = 0; ks < 4; ++ks) {
                  const s16x4 lo = __builtin_bit_cast(s16x4, __builtin_amdgcn_ds_read_tr16_b64_v4i16((LAS s16x4*)(vb + d0 * 4096 + ks * 1024)));
                  const s16x4 hi = __builtin_bit_cast(s16x4, __builtin_amdgcn_ds_read_tr16_b64_v4i16((LAS s16x4*)(vb + d0 * 4096 + ks * 1024 + 512)));
                  const bf16x8 vf = (bf16x8){lo[0], lo[1], lo[2], lo[3], hi[0], hi[1], hi[2], hi[3]};
                  if (d0 == 0) o0 = __builtin_amdgcn_mfma_f32_32x32x16_bf16(pa[ks], vf, o0, 0, 0, 0); else o1 = __builtin_amdgcn_mfma_f32_32x32x16_bf16(pa[ks], vf, o1, 0, 0, 0); } } }
    }
    }
#undef KV_DMA
    { auto rr = __builtin_amdgcn_permlane32_swap(__float_as_uint(l_reg), __float_as_uint(l_reg), false, false); l_reg = __uint_as_float(rr[0]) + __uint_as_float(rr[1]); }
    LAS float* wsf = (LAS float*)(lds + AT_WSF) + w * 64;
    if (hh == 0) wsf[c32] = l_reg;
    asm volatile("s_waitcnt lgkmcnt(0)" ::: "memory");
    LAS bf16_t* stg = (LAS bf16_t*)(lds + AT_OST) + w * 2048;
#pragma unroll
    for (int r = 0; r < 16; ++r) { const int orow = crow(r, hh); const float rl = __builtin_amdgcn_rcpf(wsf[orow]);
        stg[orow * 64 + c32] = (bf16_t)(cvt_pk_bf16(o0[r] * rl, 0.f) & 0xffffu); stg[orow * 64 + 32 + c32] = (bf16_t)(cvt_pk_bf16(o1[r] * rl, 0.f) & 0xffffu); }
    asm volatile("s_waitcnt lgkmcnt(0)" ::: "memory");
#pragma unroll
    for (int i = 0; i < 4; ++i) { const int row = i * 8 + (lane >> 3), chn = lane & 7; const u32x4 ov = *(const LAS u32x4*)(stg + row * 64 + chn * 8);
        const size_t go = (row0 + q0 + row) * 512 + w * 64 + chn * 8; const u32x4 z = *(const u32x4*)(F.ZB() + go);
        u32x4 y; y.x = cvt_pk_bf16(bf_lo(ov.x) * bf_lo(z.x), bf_hi(ov.x) * bf_hi(z.x)); y.y = cvt_pk_bf16(bf_lo(ov.y) * bf_lo(z.y), bf_hi(ov.y) * bf_hi(z.y));
        y.z = cvt_pk_bf16(bf_lo(ov.z) * bf_lo(z.z), bf_hi(ov.z) * bf_hi(z.z)); y.w = cvt_pk_bf16(bf_lo(ov.w) * bf_lo(z.w), bf_hi(ov.w) * bf_hi(z.w));
        *(u32x4*)(F.YB() + go) = y; }
#endif
    asm volatile("s_waitcnt lgkmcnt(0)" ::: "memory"); __syncthreads();
}

__device__ __forceinline__ void p3_dsa(Frame& F) {
    float gq = F.lane < 64 ? fabsf(F.qg()[F.lane]) : 0.f, gk = fabsf(F.kg()[F.lane]);
#pragma unroll
    for (int o = 1; o < 64; o <<= 1) { gq = fmaxf(gq, __shfl_xor(gq, o)); gk = fmaxf(gk, __shfl_xor(gk, o)); }
    const float cshift = 8.0f * LOG2E * gq * gk * 1.02f;
    const int b = F.vcu >> 3, s = F.vcu & 7;
    if (F.G == 256) {
        for (int i = 7; i >= 0; --i) { const int qb = (i & 1) ? 16 * (i >> 1) + 15 - s : 16 * (i >> 1) + s; dsa_unit(F, b, qb, cshift); }
    } else {
        for (int u = blockIdx.x; u < BATCH * 64; u += F.G) dsa_unit(F, u >> 6, u & 63, cshift);
    }
}

#ifndef SLOW_MASK
#define SLOW_MASK 0
#endif
__global__ void __launch_bounds__(NTHREADS, 2) mk_fwd(Args args) {
    extern __shared__ __attribute__((aligned(16))) unsigned char lds_raw[];
    cg::grid_group grid = cg::this_grid();
    Frame F;
    F.lds = (LAS unsigned char*)lds_raw;
    F.tid = threadIdx.x; F.lane = F.tid & 63; F.wave = __builtin_amdgcn_readfirstlane(F.tid >> 6);
    F.G = gridDim.x; { const int bx = blockIdx.x; F.vcu = (F.G % 8 == 0) ? (bx % 8) * (F.G / 8) + bx / 8 : bx; }
    F.a = &args;
    const int lo = args.ph_lo, hi = args.ph_hi;
#ifndef PH_MASK
#define PH_MASK 0xff
#endif
#define IN(k) (((PH_MASK >> (k)) & 1) && lo <= (k) && (k) < hi)
#ifdef TPROBE
#define STAMP(k) do { if (blockIdx.x == 0 && F.tid == 0) ((unsigned long long*)(args.ws + 768 * 1024))[k] = __builtin_amdgcn_s_memrealtime(); } while (0)
#else
#define STAMP(k) do { } while (0)
#endif
#ifndef REP_MASK
#define REP_MASK 0
#endif
#define REPS(k) (((REP_MASK >> (k)) & 1) ? 2 : 1)
#define SEAM(k) do { if (IN(k) && IN((k) + 1)) grid.sync(); STAMP((k) + 1); } while (0)
    STAMP(0);
    if (IN(0)) { p0_mod(F); p0_weights(F); } SEAM(0);
    if (IN(1)) for (int rep_ = 0; rep_ < REPS(1); ++rep_) { if (rep_) grid.sync(); p1_rows(F); } SEAM(1);
    if (IN(2)) for (int rep_ = 0; rep_ < REPS(2); ++rep_) { if (rep_) grid.sync();
        SchedTiles S{(const char*)F.H(), (const char*)F.WIN(), (size_t)256 * 1024 * 2, 0, (size_t)256 * 1024 * 2, 256, 19, F.G, (int)blockIdx.x};
        EpiProj E{F.a};
        if (SLOW_MASK & 4) pg8::slow_gemm_phase<EpiProj, SchedTiles>(F.lds, 1024, 1024, 1024, S, E); else pg8::gemm_phase<EpiProj, SchedTiles>(F.lds, 1024, 1024, 1024, S, E);
    } SEAM(2);
#ifdef DSA_ZERO
    if (IN(3)) for (int rep_ = 0; rep_ < REPS(3); ++rep_) { if (rep_) grid.sync(); p3_pool(F); u32x4* yz = (u32x4*)F.YB(); for (size_t i = (size_t)blockIdx.x * NTHREADS + F.tid; i < (size_t)MROWS * 512 / 8; i += (size_t)F.G * NTHREADS) yz[i] = (u32x4){0u, 0u, 0u, 0u}; } SEAM(3);
#else
    if (IN(3)) for (int rep_ = 0; rep_ < REPS(3); ++rep_) { if (rep_) grid.sync(); if (!(REP_MASK & 0x100) || rep_ == 0) p3_pool(F); __syncthreads(); p3_dsa(F); } SEAM(3);
#endif
    if (IN(4)) for (int rep_ = 0; rep_ < REPS(4); ++rep_) { if (rep_) grid.sync();
        SchedTiles S{(const char*)F.POOL(), (const char*)F.WPG(), (size_t)256 * 512 * 2, (size_t)256 * 2, (size_t)256 * 256 * 2, 256, 2, F.G, (int)blockIdx.x};
        EpiMix E{F.UA()  , F.ZA(), F.pscale()};
        if (SLOW_MASK & 16) pg8::slow_gemm_phase<EpiMix, SchedTiles>(F.lds, 256, 512, 256, S, E); else pg8::gemm_phase<EpiMix, SchedTiles>(F.lds, 256, 512, 256, S, E);
    } SEAM(4);
    if (IN(5)) for (int rep_ = 0; rep_ < REPS(5); ++rep_) { if (rep_) grid.sync();
        EpiMerge E{F.H()  , F.GA(), F.GB()};
        SchedMerge S{(const char*)F.UA(), (const char*)F.YB(), (const char*)F.WA(), (const char*)F.WB(), F.G, (int)blockIdx.x, 0};
        if (SLOW_MASK & 32) pg8::slow_gemm_phase<EpiMerge, SchedMerge>(F.lds, 512, 512, 512, S, E); else pg8::gemm_phase<EpiMerge, SchedMerge>(F.lds, 512, 512, 512, S, E);
    } SEAM(5);
    if (IN(6)) for (int rep_ = 0; rep_ < REPS(6); ++rep_) { if (rep_) grid.sync();
        EpiMerge E{F.H(), F.GA(), F.GB()};
        SchedMerge S{(const char*)F.UA(), (const char*)F.YB(), (const char*)F.WA(), (const char*)F.WB(), F.G, (int)blockIdx.x, 1};
        if (SLOW_MASK & 32) pg8::slow_gemm_phase<EpiMerge, SchedMerge>(F.lds, 512, 512, 512, S, E); else pg8::gemm_phase<EpiMerge, SchedMerge>(F.lds, 512, 512, 512, S, E);
    } SEAM(6);
    if (IN(7)) for (int rep_ = 0; rep_ < REPS(7); ++rep_) { if (rep_) grid.sync();
        SchedTiles S{(const char*)F.H(), (const char*)F.WOUT(), (size_t)256 * 1024 * 2, 0, (size_t)256 * 1024 * 2, 256, 4, F.G, (int)blockIdx.x};
        EpiOut E{F.x(), F.out(), F.MOD()};
        if (SLOW_MASK & 64) pg8::slow_gemm_phase<EpiOut, SchedTiles>(F.lds, 1024, 1024, 1024, S, E); else pg8::gemm_phase<EpiOut, SchedTiles>(F.lds, 1024, 1024, 1024, S, E);
    }
    STAMP(8);
#undef IN
#undef SEAM
}


#ifdef TPROBE
__global__ void tp_encode(const unsigned long long* ts, float* out, int pa, int pb) {
    const float A = fmaxf(1.f, (float)(ts[pa + 1] - ts[pa]) * (1.0f / 2000.0f));
    const long n = (long)((float)(ts[pb + 1] - ts[pb]) * (1.0f / 100.0f) * 1000.0f);
    const long i = (long)blockIdx.x * 256 + threadIdx.x;
    if (i == 0) out[0] += A;
    if (i < n) out[1024 + i] += 0.5f;
}
#endif

#ifdef DIAG
#ifndef DIAG_B
#define DIAG_B 5
#endif
#ifndef DIAG_ONLY
#define DIAG_ONLY -1
#endif
extern "C" void kernel_launch(void* const* d_in, const int* in_sizes, int n_in, void* d_out, int out_size, void* d_ws, size_t ws_size, hipStream_t stream) {
    static int grid = 0;
    if (grid == 0) { int dev = 0, cus = 0; hipGetDevice(&dev); hipDeviceGetAttribute(&cus, hipDeviceAttributeMultiprocessorCount, dev);
        hipFuncSetAttribute((const void*)mk_fwd, hipFuncAttributeMaxDynamicSharedMemorySize, LDS_BYTES); grid = cus; }
    (void)hipMemsetAsync((char*)d_ws + WS_CTL, 0, CTL_ZERO_BYTES, stream);
    unsigned char* ws = (unsigned char*)d_ws; float* out = (float*)d_out;
    unsigned* res = (unsigned*)(ws + 512 * 1024);
    const nv::Bufs G = nv::carve(ws + 840 * MiB); float* gout = (float*)(ws + 960 * MiB); const int b = DIAG_B;
    nv::run_mod(d_in, G, stream); nv::run_batch(d_in, out, G, b, stream);
    dg::copy_f<<<SEQ * 1024 / 256, 256, 0, stream>>>(out + (size_t)b * SEQ * 1024, gout, (long)SEQ * 1024);
    Args a{}; for (int i = 0; i < 14; ++i) a.in[i] = d_in[i]; a.out = out; a.ws = ws;
    auto phase = [&](int p) { a.ph_lo = p; a.ph_hi = p + 1; hipLaunchKernelGGL(mk_fwd, dim3(grid), dim3(NTHREADS), LDS_BYTES, stream, a); };
    auto check = [&](int kind, long n) { dg::chk<<<(unsigned)((n + 255) / 256), 256, 0, stream>>>(kind, b, ws, out, G, gout, res, n); };
    const long R = SEQ;
    phase(0); phase(1); phase(2);
    check(0, 32 * 3072); check(1, R * 1024); check(2, R * 512); check(3, R * 512); check(4, R * 512); check(5, R * 64); check(6, R * 64); check(7, R * 512);
    check(8, R * 512); check(9, R * 64); check(10, R * 8); check(11, R * 1024); check(12, R * 1024);
    phase(3); check(13, R * 512); check(15, R * 512);
    phase(4); check(14, R * 512);
    phase(5); check(16, R * 1024);
    phase(6); check(17, R * 1024);
    phase(7); check(18, R * 1024);
    nv::run(d_in, out, ws + 840 * MiB, stream);
    dg::encode<<<1, 64, 0, stream>>>(res, out, DIAG_ONLY);
}
#else
#ifndef MK_N_LAUNCHES
#define MK_N_LAUNCHES 1
#endif
extern "C" void kernel_launch(void* const* d_in, const int* in_sizes, int n_in, void* d_out, int out_size, void* d_ws, size_t ws_size, hipStream_t stream) {
    static int grid = 0;
    if (grid == 0) {
        int dev = 0, cus = 0, per_cu = 0;
        if (hipGetDevice(&dev) != hipSuccess || hipDeviceGetAttribute(&cus, hipDeviceAttributeMultiprocessorCount, dev) != hipSuccess) { fprintf(stderr, "kernel_launch: device query failed\n"); grid = -1; return; }
        if (hipFuncSetAttribute((const void*)mk_fwd, hipFuncAttributeMaxDynamicSharedMemorySize, LDS_BYTES) != hipSuccess) { fprintf(stderr, "kernel_launch: hipFuncSetAttribute failed\n"); grid = -1; return; }
        if (hipOccupancyMaxActiveBlocksPerMultiprocessor(&per_cu, (const void*)mk_fwd, NTHREADS, LDS_BYTES) != hipSuccess || per_cu < 1) { fprintf(stderr, "kernel_launch: occupancy query says %d blocks per CU\n", per_cu); grid = -1; return; }
        grid = cus * 1;
        if (n_in != 14 || ws_size < WS_END) { fprintf(stderr, "kernel_launch: unexpected inputs (%d) or workspace (%zu)\n", n_in, ws_size); grid = -1; return; }
    }
    if (grid < 0) return;
    (void)hipMemsetAsync((char*)d_ws + WS_CTL, 0, CTL_ZERO_BYTES, stream);
    Args a{};
    for (int i = 0; i < 14; ++i) a.in[i] = d_in[i];
    a.out = (float*)d_out; a.ws = (unsigned char*)d_ws;
#if MK_N_LAUNCHES == 1
    a.ph_lo = 0; a.ph_hi = 8;
    void* kargs[] = {&a};
    const hipError_t e = hipLaunchCooperativeKernel((const void*)mk_fwd, dim3(grid), dim3(NTHREADS), kargs, LDS_BYTES, stream);
    if (e != hipSuccess) fprintf(stderr, "kernel_launch: cooperative launch failed: %s (grid %d)\n", hipGetErrorString(e), grid);
#ifdef TPROBE
    tp_encode<<<8192, 256, 0, stream>>>((const unsigned long long*)((char*)d_ws + 768 * 1024), (float*)d_out, TP_A, TP_B);
#endif
#else
    for (int p = 0; p < 8; ++p) { a.ph_lo = p; a.ph_hi = p + 1; hipLaunchKernelGGL(mk_fwd, dim3(grid), dim3(NTHREADS), LDS_BYTES, stream, a); }
#endif
}
#endif
```
